# Optimizing an MI355X kernel written in HIP

```python
import jax, jax.numpy as jnp
from jax import lax
import numpy as np

D_MODEL = 1024
BATCH = 2
SEQ = 8192
DEPTH = 1
DEC_BATCH = 128
DEC_SEQ = 1
PAST_LEN = 2048
PAGE_SIZE = 128

HEAD_DIM = 64
ATT_WIDTH = D_MODEL // 2
N_HEADS = ATT_WIDTH // HEAD_DIM
POOL_WIDTH = D_MODEL - ATT_WIDTH
POOL_WINDOWS = (2, 4, 8, 16)
POOL_GROUPS = len(POOL_WINDOWS)
POOL_GC = POOL_WIDTH // POOL_GROUPS
POOL_STATE = max(POOL_WINDOWS) - 1
IN_WIDTH = POOL_WIDTH + 3 * ATT_WIDTH
MOBA_BLOCK = 256
MOBA_TOPK = 3
Q_BLOCK = 128
D_FF = 2816
CONV_WIDTH = 3
ROPE_THETA = 10000.0
RMS_EPS = 1e-6

kernel_name = "hymba_pool_moba_convffn_step"


def rmsnorm(x, g):
    xf = x.astype(jnp.float32)
    y = xf * lax.rsqrt(jnp.mean(xf * xf, axis=-1, keepdims=True) + RMS_EPS)
    return (y * g.astype(jnp.float32)).astype(x.dtype)


def modulate(h, shift, scale):
    return h * (1 + scale) + shift


def rope(x, positions):
    half = x.shape[-1] // 2
    inv = ROPE_THETA ** (-jnp.arange(half, dtype=jnp.float32) / half)
    ang = positions.astype(jnp.float32)[:, None] * inv[None, :]
    cos = jnp.cos(ang)[None, :, None, :]
    sin = jnp.sin(ang)[None, :, None, :]
    xf = x.astype(jnp.float32)
    x1, x2 = xf[..., :half], xf[..., half:]
    return jnp.concatenate([x1 * cos - x2 * sin, x2 * cos + x1 * sin], axis=-1).astype(x.dtype)


def pool_mixer(u, prev, pos0, pool_w, pool_scale):
    b, t_len, c = u.shape
    full = u if prev is None else jnp.concatenate([prev.astype(u.dtype), u], axis=1)
    p_len = full.shape[1] - t_len
    cs = jnp.pad(jnp.cumsum(full.astype(jnp.float32), axis=1), ((0, 0), (1, 0), (0, 0)))
    t = jnp.arange(t_len, dtype=jnp.int32)
    pos = pos0 + t
    uf = u.astype(jnp.float32)
    groups = []
    for g, w in enumerate(POOL_WINDOWS):
        lo, hi = g * POOL_GC, (g + 1) * POOL_GC
        cs_g = cs[:, :, lo:hi]
        start = jnp.maximum(p_len + 1 + t - w, 0)
        win_sum = cs_g[:, p_len + 1:] - cs_g[:, start]
        count = jnp.minimum(w, pos + 1).astype(jnp.float32)[:, None]
        groups.append(win_sum / count - uf[..., lo:hi])
    pooled = jnp.stack(groups, axis=2)
    out = jnp.einsum("btgc,gcd->btgd", pooled, pool_w.astype(jnp.float32)).reshape(b, t_len, c)
    out = (out * pool_scale.astype(jnp.float32)).astype(u.dtype)
    return out, full[:, -POOL_STATE:]


def moba_attend(q, q_pos, k_blocks, v_blocks, k_means):
    b, h, nq, dh = q.shape
    nb = k_blocks.shape[2]
    kk = min(MOBA_TOPK, nb)
    qf = q.astype(jnp.float32)
    own = q_pos // MOBA_BLOCK
    gate = jnp.einsum("bhqd,bhnd->bhqn", qf, k_means)
    fully_past = jnp.arange(nb)[None, :] < own[:, None]
    gate = jnp.where(fully_past, gate, -jnp.inf)
    _, sel = lax.top_k(gate, kk)
    sel_ok = sel < own[:, None]
    own_b = jnp.broadcast_to(own[:, None], (b, h, nq, 1)).astype(sel.dtype)
    blk = jnp.concatenate([sel, own_b], axis=-1)
    ok = jnp.concatenate([sel_ok, jnp.ones((b, h, nq, 1), dtype=bool)], axis=-1)
    bi = jnp.arange(b)[:, None, None, None]
    hi = jnp.arange(h)[None, :, None, None]
    kg = k_blocks[bi, hi, blk].astype(jnp.float32)
    vg = v_blocks[bi, hi, blk].astype(jnp.float32)
    s = jnp.einsum("bhqd,bhqnkd->bhqnk", qf, kg) * (dh ** -0.5)
    kpos = blk[..., None] * MOBA_BLOCK + jnp.arange(MOBA_BLOCK, dtype=blk.dtype)
    mask = ok[..., None] & (kpos <= q_pos[:, None, None])
    s = jnp.where(mask, s, -jnp.inf)
    p = jax.nn.softmax(s.reshape(b, h, nq, -1), axis=-1).reshape(s.shape)
    out = jnp.einsum("bhqnk,bhqnkd->bhqd", p, vg)
    return out.astype(q.dtype)


def moba_mixer(q, k, v, positions, past_k, past_v):
    b, t_len, h, dh = q.shape
    kf = k if past_k is None else jnp.concatenate([past_k.astype(k.dtype), k], axis=1)
    vf = v if past_v is None else jnp.concatenate([past_v.astype(v.dtype), v], axis=1)
    total = kf.shape[1]
    nb = -(-total // MOBA_BLOCK)
    pad = nb * MOBA_BLOCK - total
    kb = jnp.pad(kf, ((0, 0), (0, pad), (0, 0), (0, 0))).reshape(b, nb, MOBA_BLOCK, h, dh).transpose(0, 3, 1, 2, 4)
    vb = jnp.pad(vf, ((0, 0), (0, pad), (0, 0), (0, 0))).reshape(b, nb, MOBA_BLOCK, h, dh).transpose(0, 3, 1, 2, 4)
    k_means = jnp.mean(kb.astype(jnp.float32), axis=3)
    qh = q.transpose(0, 2, 1, 3)
    if t_len > Q_BLOCK and t_len % Q_BLOCK == 0:
        n_qb = t_len // Q_BLOCK
        qs = qh.reshape(b, h, n_qb, Q_BLOCK, dh).transpose(2, 0, 1, 3, 4)
        ps = positions.reshape(n_qb, Q_BLOCK)
        out = lax.map(lambda a: moba_attend(a[0], a[1], kb, vb, k_means), (qs, ps))
        out = out.transpose(1, 2, 0, 3, 4).reshape(b, h, t_len, dh)
    else:
        out = moba_attend(qh, positions, kb, vb, k_means)
    return out.transpose(0, 2, 1, 3).reshape(b, t_len, h * dh)


def conv_ffn(h, prev, w_up, conv_w, conv_b, w_down):
    up = h @ w_up
    b, t_len, c = up.shape
    if prev is None:
        prev = jnp.zeros((b, CONV_WIDTH - 1, c), up.dtype)
    full = jnp.concatenate([prev.astype(up.dtype), up], axis=1)
    conv = conv_b + sum(conv_w[j] * full[:, j:j + t_len] for j in range(CONV_WIDTH))
    a, g = jnp.split(conv, 2, axis=-1)
    out = (jax.nn.silu(a) * g) @ w_down
    return out, full[:, -(CONV_WIDTH - 1):]


def decoder_layer(x, c, pos0, pool_prev, conv_prev, past_k, past_v,
                  w_ada, b_ada, g_mix_pre, g_mix_post, w_in, pool_w, pool_scale, w_out,
                  g_ffn_pre, g_ffn_post, w_up, conv_w, conv_b, w_down):
    b, t_len, _ = x.shape
    mod = (jax.nn.silu(c) @ w_ada + b_ada)[:, None, :]
    sh1, sc1, gt1, sh2, sc2, gt2 = jnp.split(mod, 6, axis=-1)
    positions = pos0 + jnp.arange(t_len, dtype=jnp.int32)
    h = modulate(rmsnorm(x, g_mix_pre), sh1, sc1)
    proj = h @ w_in
    u, q, k, v = jnp.split(proj, [POOL_WIDTH, POOL_WIDTH + ATT_WIDTH, POOL_WIDTH + 2 * ATT_WIDTH], axis=-1)
    pool_out, pool_new = pool_mixer(u, pool_prev, pos0, pool_w, pool_scale)
    q = rope(q.reshape(b, t_len, N_HEADS, HEAD_DIM), positions)
    k = rope(k.reshape(b, t_len, N_HEADS, HEAD_DIM), positions)
    v = v.reshape(b, t_len, N_HEADS, HEAD_DIM)
    att_out = moba_mixer(q, k, v, positions, past_k, past_v)
    mix = jnp.concatenate([pool_out.astype(x.dtype), att_out.astype(x.dtype)], axis=-1) @ w_out
    x = x + gt1 * rmsnorm(mix, g_mix_post)
    h2 = modulate(rmsnorm(x, g_ffn_pre), sh2, sc2)
    ffn_out, conv_new = conv_ffn(h2, conv_prev, w_up, conv_w, conv_b, w_down)
    x = x + gt2 * rmsnorm(ffn_out, g_ffn_post)
    return x, k, v, pool_new, conv_new


def setup_inputs(seed: int = 0) -> dict:
    key = jax.random.key(seed)
    ks = jax.random.split(key, 24)
    f32 = jnp.float32
    n_pages = PAST_LEN // PAGE_SIZE
    n_phys = (DEC_BATCH * n_pages * 5) // 4

    def nrm(k, shape, scale):
        return jax.random.normal(k, shape, f32) * scale

    page_table = jax.random.permutation(ks[6], n_phys)[: DEC_BATCH * n_pages].reshape(DEC_BATCH, n_pages).astype(jnp.int32)
    return {
        "x_prompt": nrm(ks[0], (BATCH, SEQ, D_MODEL), 1.0),
        "x_sample": nrm(ks[1], (DEC_BATCH, DEC_SEQ, D_MODEL), 1.0),
        "c_prompt": nrm(ks[2], (BATCH, D_MODEL), 1.0),
        "c_sample": nrm(ks[3], (DEC_BATCH, D_MODEL), 1.0),
        "cache_k": nrm(ks[4], (DEPTH, n_phys, PAGE_SIZE, N_HEADS, HEAD_DIM), 1.0),
        "cache_v": nrm(ks[5], (DEPTH, n_phys, PAGE_SIZE, N_HEADS, HEAD_DIM), 1.0),
        "page_table": page_table,
        "state_pool": nrm(ks[7], (DEPTH, DEC_BATCH, POOL_STATE, POOL_WIDTH), 1.0),
        "state_conv": nrm(ks[8], (DEPTH, DEC_BATCH, CONV_WIDTH - 1, 2 * D_FF), 1.0),
        "w_ada": nrm(ks[9], (DEPTH, D_MODEL, 6 * D_MODEL), 0.5 * D_MODEL ** -0.5),
        "b_ada": nrm(ks[10], (DEPTH, 6 * D_MODEL), 0.01),
        "g_mix_pre": 1.0 + nrm(ks[11], (DEPTH, D_MODEL), 0.1),
        "g_mix_post": 1.0 + nrm(ks[12], (DEPTH, D_MODEL), 0.1),
        "w_in": nrm(ks[13], (DEPTH, D_MODEL, IN_WIDTH), D_MODEL ** -0.5),
        "pool_w": nrm(ks[14], (DEPTH, POOL_GROUPS, POOL_GC, POOL_GC), POOL_GC ** -0.5),
        "pool_scale": 1.0 + nrm(ks[15], (DEPTH, POOL_WIDTH), 0.1),
        "w_out": nrm(ks[16], (DEPTH, D_MODEL, D_MODEL), D_MODEL ** -0.5),
        "g_ffn_pre": 1.0 + nrm(ks[17], (DEPTH, D_MODEL), 0.1),
        "g_ffn_post": 1.0 + nrm(ks[18], (DEPTH, D_MODEL), 0.1),
        "w_up": nrm(ks[19], (DEPTH, D_MODEL, 2 * D_FF), D_MODEL ** -0.5),
        "conv_w": nrm(ks[20], (DEPTH, CONV_WIDTH, 2 * D_FF), CONV_WIDTH ** -0.5),
        "conv_b": nrm(ks[21], (DEPTH, 2 * D_FF), 0.02),
        "w_down": nrm(ks[22], (DEPTH, D_FF, D_MODEL), D_FF ** -0.5),
    }


def reference(x_prompt, x_sample, c_prompt, c_sample, cache_k, cache_v, page_table, state_pool, state_conv,
              w_ada, b_ada, g_mix_pre, g_mix_post, w_in, pool_w, pool_scale, w_out,
              g_ffn_pre, g_ffn_post, w_up, conv_w, conv_b, w_down):
    dec_b, n_pages = page_table.shape
    past_len = n_pages * cache_k.shape[2]
    y_p, y_s = x_prompt, x_sample
    kp_l, vp_l, pp_l, cp_l = [], [], [], []
    ks_l, vs_l, ps_l, cs_l = [], [], [], []
    for l in range(DEPTH):
        lw = (w_ada[l], b_ada[l], g_mix_pre[l], g_mix_post[l], w_in[l], pool_w[l], pool_scale[l], w_out[l],
              g_ffn_pre[l], g_ffn_post[l], w_up[l], conv_w[l], conv_b[l], w_down[l])
        y_p, kp, vp, pp, cp = decoder_layer(y_p, c_prompt, 0, None, None, None, None, *lw)
        past_k = cache_k[l][page_table].reshape(dec_b, past_len, N_HEADS, HEAD_DIM)
        past_v = cache_v[l][page_table].reshape(dec_b, past_len, N_HEADS, HEAD_DIM)
        y_s, ksn, vsn, psn, csn = decoder_layer(y_s, c_sample, past_len, state_pool[l], state_conv[l],
                                                past_k, past_v, *lw)
        kp_l.append(kp); vp_l.append(vp); pp_l.append(pp); cp_l.append(cp)
        ks_l.append(ksn); vs_l.append(vsn); ps_l.append(psn); cs_l.append(csn)
    k_prompt = jnp.stack(kp_l)
    v_prompt = jnp.stack(vp_l)
    pool_prompt = jnp.stack(pp_l)
    conv_prompt = jnp.stack(cp_l)
    k_sample = jnp.stack(ks_l)
    v_sample = jnp.stack(vs_l)
    pool_sample = jnp.stack(ps_l)
    conv_sample = jnp.stack(cs_l)
    return (y_p, y_s, k_prompt, v_prompt, pool_prompt, conv_prompt, k_sample, v_sample, pool_sample, conv_sample)
```

```cpp
#include <hip/hip_runtime.h>
#include <cstdio>
#include <cstdint>
namespace pg8 {
#define PG8_LAS __attribute__((address_space(3)))
typedef unsigned short bf16_t;
typedef short bf16x8 __attribute__((ext_vector_type(8)));
typedef float f32x4 __attribute__((ext_vector_type(4)));
typedef unsigned u32x4 __attribute__((ext_vector_type(4)));
constexpr int BM = 256, BK = 64, HALF = 128, HTB = HALF * BK * 2  , STAGE_BYTES = 8 * HTB, NXCD = 8, WGM = 8;

__host__ __device__ __forceinline__ int lds_byte(int r, int c) { const int st = (r >> 4) * 2 + (c >> 5), rr = r & 15, cc = c & 31, ob = rr * 64 + cc * 2; return st * 1024 + (ob ^ (((ob >> 9) & 1) << 5)); }
__host__ __device__ __forceinline__ void stage_rc(int b, int& R, int& C) { const int st = b / 1024, sb = b % 1024, swz = sb ^ (((sb >> 9) & 1) << 5); R = (st >> 1) * 16 + swz / 64; C = (st & 1) * 32 + (swz % 64) / 2; }
__host__ __device__ __forceinline__ int perm32(int rho) { const int n = rho >> 4, i = rho & 15; return 8 * (i >> 2) + 4 * n + (i & 3); }

struct Unit { int pm, pn; };
struct Gemm { const bf16_t* A; const bf16_t* Bt; int M, N, K; };

struct StaticOrder {
    int nM, nN, nwg, G, c;
    __host__ __device__ void init(int M, int N, int G_, int c_) { nM = M / BM; nN = N / BM; nwg = nM * nN; G = G_; c = c_; }
    __host__ __device__ bool next(int i, Unit& u) const {
        const long L = (long)i * G + c; if (L >= nwg) return false;
        int wgid = (int)L; { const int q = nwg / NXCD, r = nwg % NXCD, xcd = wgid % NXCD, off = wgid / NXCD; wgid = (xcd < r ? xcd * (q + 1) : r * (q + 1) + (xcd - r) * q) + off; }
        const int nig = WGM * nN, gid = wgid / nig, fm = gid * WGM, gsz = (nM - fm) < WGM ? (nM - fm) : WGM;
        u.pm = fm + ((wgid % nig) % gsz); u.pn = (wgid % nig) / gsz; return true;
    }
    __device__ __forceinline__ void a_ready(const Unit&) const {}
    __device__ __forceinline__ void done(const Unit&) const {}
};

__device__ __forceinline__ unsigned cvt_pk_bf16(float lo, float hi) { unsigned r; asm volatile("v_cvt_pk_bf16_f32 %0, %1, %2" : "=v"(r) : "v"(lo), "v"(hi)); return r; }
typedef float f32x2 __attribute__((ext_vector_type(2)));
__device__ __forceinline__ f32x2 gelu_pk(f32x2 v) {
    const f32x2 av = __builtin_elementwise_abs(v), d = av * 0.2316418882f + 1.0f;
    f32x2 t; t.x = __builtin_amdgcn_rcpf(d.x); t.y = __builtin_amdgcn_rcpf(d.y);
    f32x2 q = t * 0.5307027145f + (-0.7265760135f); q = q * t + 0.7107068705f; q = q * t + (-0.142248368f); q = q * t + 0.127414796f; q = q * t;
    const f32x2 s = (v * v) * (-0.72134752044f);
    f32x2 e; e.x = __builtin_amdgcn_exp2f(s.x); e.y = __builtin_amdgcn_exp2f(s.y);
    const f32x2 m = v * (q * e), r = v - m;
    f32x2 o; o.x = v.x < 0.f ? m.x : r.x; o.y = v.y < 0.f ? m.y : r.y; return o;
}

template <int ACT  > struct EpiBf16 {
    static constexpr bool PERM = true, AFTER_DRAIN = false; static_assert(ACT == 0 || ACT == 1, "EpiBf16: ACT is 0 (none) or 1 (gelu_pk)");
    bf16_t* O; int ldc; const float* bias; int split_cols; size_t split_stride; float scale0;
    __device__ __forceinline__ void operator()(const f32x4 (&acc)[2][2][4][2], const Unit& u, int wr, int wc, int fr, int fq) const {
        const int row0 = u.pm * BM + wr * 64 + fr; int colt = u.pn * BM; bf16_t* base = O;
        float sc = 1.f; if (split_cols) { const int t = colt / split_cols; base += (size_t)t * split_stride; colt -= t * split_cols; if (t == 0) sc = scale0; }
        const int col0 = colt + wc * 32 + 8 * fq, bcol0 = u.pn * BM + wc * 32 + 8 * fq;
        f32x4 bv[2][2];
#pragma unroll
        for (int bj = 0; bj < 2; ++bj)
#pragma unroll
            for (int n = 0; n < 2; ++n) bv[bj][n] = bias ? *(const f32x4*)(bias + bcol0 + bj * HALF + 4 * n) : (f32x4){0.f, 0.f, 0.f, 0.f};
#pragma unroll
        for (int ai = 0; ai < 2; ++ai)
#pragma unroll
            for (int m = 0; m < 4; ++m) { bf16_t* rowp = base + (size_t)(row0 + ai * HALF + m * 16) * ldc + col0;
#pragma unroll
                for (int bj = 0; bj < 2; ++bj) { f32x4 v0 = acc[ai][bj][m][0] + bv[bj][0], v1 = acc[ai][bj][m][1] + bv[bj][1];
                    if (ACT == 1) { f32x2 a = gelu_pk((f32x2){v0[0], v0[1]}), b = gelu_pk((f32x2){v0[2], v0[3]}), c = gelu_pk((f32x2){v1[0], v1[1]}), d = gelu_pk((f32x2){v1[2], v1[3]});
                        v0 = (f32x4){a.x, a.y, b.x, b.y}; v1 = (f32x4){c.x, c.y, d.x, d.y}; }
                    v0 = v0 * sc; v1 = v1 * sc; u32x4 w; w.x = cvt_pk_bf16(v0[0], v0[1]); w.y = cvt_pk_bf16(v0[2], v0[3]); w.z = cvt_pk_bf16(v1[0], v1[1]); w.w = cvt_pk_bf16(v1[2], v1[3]);
                    *(u32x4*)(rowp + bj * HALF) = w; } }
    }
};

struct PanelStats {
    unsigned* xbuf;
    unsigned* cnt;
    unsigned* tmo;
    int ntn; float eps;
    unsigned code;
    __device__ __forceinline__ bool run(const f32x4 (&v)[2][2][4][2], const Unit& u, int wr, int wc, int fr, int fq, PG8_LAS unsigned char* lds, int wid, int lane) const {
        typedef float f32x2v __attribute__((ext_vector_type(2)));
        PG8_LAS f32x2v* P = (PG8_LAS f32x2v*)lds;
        PG8_LAS f32x2v* S = (PG8_LAS f32x2v*)(lds + 8192);
        PG8_LAS unsigned* flag = (PG8_LAS unsigned*)(lds + 8192 + 2048);
#pragma unroll
        for (int ai = 0; ai < 2; ++ai)
#pragma unroll
            for (int m = 0; m < 4; ++m) {
                float s = 0.f;
#pragma unroll
                for (int bj = 0; bj < 2; ++bj)
#pragma unroll
                    for (int n = 0; n < 2; ++n) { const f32x4 x = v[ai][bj][m][n]; s += (x[0] + x[1]) + (x[2] + x[3]); }
                s += __shfl_xor(s, 16); s += __shfl_xor(s, 32);
                const float mw = s * (1.0f / 64.0f); float q = 0.f;
#pragma unroll
                for (int bj = 0; bj < 2; ++bj)
#pragma unroll
                    for (int n = 0; n < 2; ++n) { const f32x4 d = v[ai][bj][m][n] - mw; q += (d[0] * d[0] + d[1] * d[1]) + (d[2] * d[2] + d[3] * d[3]); }
                q += __shfl_xor(q, 16); q += __shfl_xor(q, 32);
                if (fq == 0) P[(ai * HALF + wr * 64 + m * 16 + fr) * 4 + wc] = (f32x2v){mw, q};
            }
        asm volatile("s_waitcnt lgkmcnt(0)" ::: "memory"); __builtin_amdgcn_s_barrier(); asm volatile("" ::: "memory");
#if defined(BROKEN_EXCHANGE_NO_WAIT)
#warning BROKEN CONTROL BUILD: the row-statistics exchange does not wait; results are wrong by design
        if (blockIdx.x >= 64) { const long long t0_ = clock64(); while (clock64() - t0_ < 60000) __builtin_amdgcn_s_sleep(8); }
#endif
        const int row = wid * 32 + (lane & 31);
        if (lane < 32) {
            const f32x2v a = P[row * 4 + 0], b = P[row * 4 + 1], c = P[row * 4 + 2], d = P[row * 4 + 3];
            const float mt = (a.x + b.x + c.x + d.x) * 0.25f;
            const float da = a.x - mt, db = b.x - mt, dc = c.x - mt, dd = d.x - mt;
            const float m2 = (a.y + b.y) + (c.y + d.y) + 64.0f * ((da * da + db * db) + (dc * dc + dd * dd));
            unsigned long long* slot = (unsigned long long*)xbuf + ((size_t)(u.pm * BM + row) * 4 + u.pn);
            __hip_atomic_store(slot, ((unsigned long long)__float_as_uint(m2) << 32) | __float_as_uint(mt), __ATOMIC_RELAXED, __HIP_MEMORY_SCOPE_AGENT);
        }
        asm volatile("s_waitcnt vmcnt(0)" ::: "memory");
        if (lane == 0) __hip_atomic_fetch_add(cnt + 64 * u.pm, 1u, __ATOMIC_RELAXED, __HIP_MEMORY_SCOPE_AGENT);
        if (wid == 0) {
            bool dead = false; const unsigned long long t0 = __builtin_amdgcn_s_memrealtime(); const unsigned want = 8u * (unsigned)ntn;
            for (;;) {
#if defined(BROKEN_EXCHANGE_NO_WAIT)
                break;
#endif
                if ((unsigned)__builtin_amdgcn_readfirstlane(__hip_atomic_load(cnt + 64 * u.pm, __ATOMIC_RELAXED, __HIP_MEMORY_SCOPE_AGENT)) >= want) break;
                if (__builtin_amdgcn_s_memrealtime() - t0 > 2000000ull) {
                    if (lane == 0) { unsigned expect = 0u; __hip_atomic_compare_exchange_strong(tmo + 1, &expect, code | (unsigned)(u.pm & 0xff), __ATOMIC_RELAXED, __ATOMIC_RELAXED, __HIP_MEMORY_SCOPE_AGENT);
                                     __hip_atomic_store(tmo, 1u, __ATOMIC_RELAXED, __HIP_MEMORY_SCOPE_AGENT); }
                    dead = true; break; }
                __builtin_amdgcn_s_sleep(2);
            }
            __builtin_amdgcn_fence(__ATOMIC_ACQUIRE, "agent");
            if (lane == 0) flag[0] = dead ? 1u : 0u;
        }
        asm volatile("s_waitcnt vmcnt(0) lgkmcnt(0)" ::: "memory"); __builtin_amdgcn_s_barrier(); asm volatile("" ::: "memory");
        const bool bad = flag[0] != 0u;
        if (lane < 32) {
            const unsigned long long* slot = (const unsigned long long*)xbuf + (size_t)(u.pm * BM + row) * 4; float mt[4], m2[4]; float ms = 0.f;
#pragma unroll
            for (int t = 0; t < 4; ++t) { if (t < ntn) { const unsigned long long w = __hip_atomic_load(slot + t, __ATOMIC_RELAXED, __HIP_MEMORY_SCOPE_AGENT); mt[t] = __uint_as_float((unsigned)w); m2[t] = __uint_as_float((unsigned)(w >> 32)); } else { mt[t] = 0.f; m2[t] = 0.f; } ms += mt[t]; }
            const float mean = ms / (float)ntn; float q = 0.f;
#pragma unroll
            for (int t = 0; t < 4; ++t) if (t < ntn) { const float dm = mt[t] - mean; q += m2[t] + 256.0f * dm * dm; }
            S[row] = (f32x2v){mean, 1.0f / sqrtf(q / (256.0f * (float)ntn) + eps)};
        }
        asm volatile("s_waitcnt lgkmcnt(0)" ::: "memory"); __builtin_amdgcn_s_barrier(); asm volatile("" ::: "memory");
        return bad;
    }
};
struct EpiLnRes {
    static constexpr bool PERM = false, AFTER_DRAIN = true;
    const float* base; float* out; int ldc; const float* bias; PanelStats st; unsigned poison;
    __device__ __forceinline__ void fused(f32x4 (&acc)[2][2][4][2], const Unit& u, int wr, int wc, int fr, int fq, PG8_LAS unsigned char* lds, int wid, int lane) const {
        typedef float f32x2v __attribute__((ext_vector_type(2)));
        const PG8_LAS f32x2v* S = (const PG8_LAS f32x2v*)(lds + 8192);
        const int col0 = u.pn * BM + wc * 32 + 4 * fq;
#pragma unroll
        for (int bj = 0; bj < 2; ++bj)
#pragma unroll
            for (int n = 0; n < 2; ++n) { const f32x4 bv = bias ? *(const f32x4*)(bias + col0 + bj * HALF + n * 16) : (f32x4){0.f, 0.f, 0.f, 0.f};
#pragma unroll
                for (int ai = 0; ai < 2; ++ai)
#pragma unroll
                    for (int m = 0; m < 4; ++m) acc[ai][bj][m][n] += bv; }
        f32x4 pre[4][2][2];
#pragma unroll
        for (int m = 0; m < 4; ++m) { const size_t off = (size_t)(u.pm * BM + wr * 64 + m * 16 + fr) * ldc + col0;
#pragma unroll
            for (int bj = 0; bj < 2; ++bj)
#pragma unroll
                for (int n = 0; n < 2; ++n) pre[m][bj][n] = *(const f32x4*)(base + off + bj * HALF + n * 16); }
        const bool bad = st.run(acc, u, wr, wc, fr, fq, lds, wid, lane) || poison != 0u;
        const float qnan = __builtin_nanf("");
#pragma unroll
        for (int ai = 0; ai < 2; ++ai)
#pragma unroll
            for (int m = 0; m < 4; ++m) { const int r = ai * HALF + wr * 64 + m * 16 + fr; const f32x2v sr = S[r]; const size_t off = (size_t)(u.pm * BM + r) * ldc + col0;
#pragma unroll
                for (int bj = 0; bj < 2; ++bj)
#pragma unroll
                    for (int n = 0; n < 2; ++n) { const f32x4 bs = ai == 0 ? pre[m][bj][n] : *(const f32x4*)(base + off + bj * HALF + n * 16); f32x4 o = bs + (acc[ai][bj][m][n] - sr.x) * sr.y;
                        if (bad) o = (f32x4){qnan, qnan, qnan, qnan}; *(f32x4*)(out + off + bj * HALF + n * 16) = o; }
                if (m & 1) asm volatile("" ::: "memory"); }
    }
};
struct EpiLnResLn {
    static constexpr bool PERM = false, AFTER_DRAIN = true;
    const float* base; float* out; bf16_t* xn; int ldc; const float* bias; PanelStats st1, st2; unsigned poison;
    __device__ __forceinline__ void fused(f32x4 (&acc)[2][2][4][2], const Unit& u, int wr, int wc, int fr, int fq, PG8_LAS unsigned char* lds, int wid, int lane) const {
        typedef float f32x2v __attribute__((ext_vector_type(2))); typedef unsigned u32x2v __attribute__((ext_vector_type(2)));
        const PG8_LAS f32x2v* S = (const PG8_LAS f32x2v*)(lds + 8192);
        const int col0 = u.pn * BM + wc * 32 + 4 * fq;
#pragma unroll
        for (int bj = 0; bj < 2; ++bj)
#pragma unroll
            for (int n = 0; n < 2; ++n) { const f32x4 bv = bias ? *(const f32x4*)(bias + col0 + bj * HALF + n * 16) : (f32x4){0.f, 0.f, 0.f, 0.f};
#pragma unroll
                for (int ai = 0; ai < 2; ++ai)
#pragma unroll
                    for (int m = 0; m < 4; ++m) acc[ai][bj][m][n] += bv; }
        bool bad = st1.run(acc, u, wr, wc, fr, fq, lds, wid, lane) || poison != 0u;
        const float qnan = __builtin_nanf("");
#pragma unroll
        for (int ai = 0; ai < 2; ++ai)
#pragma unroll
            for (int m = 0; m < 4; ++m) { const int r = ai * HALF + wr * 64 + m * 16 + fr; const f32x2v sr = S[r]; const size_t off = (size_t)(u.pm * BM + r) * ldc + col0;
#pragma unroll
                for (int bj = 0; bj < 2; ++bj)
#pragma unroll
                    for (int n = 0; n < 2; ++n) { const f32x4 bs = *(const f32x4*)(base + off + bj * HALF + n * 16); acc[ai][bj][m][n] = bs + (acc[ai][bj][m][n] - sr.x) * sr.y; }
                asm volatile("" : "+v"(acc[ai][0][m][0]), "+v"(acc[ai][0][m][1]), "+v"(acc[ai][1][m][0]), "+v"(acc[ai][1][m][1]));
                if (m & 1) asm volatile("" ::: "memory"); }
        const bool bad1 = bad;
        bad = st2.run(acc, u, wr, wc, fr, fq, lds, wid, lane) || bad;
#pragma unroll
        for (int ai = 0; ai < 2; ++ai)
#pragma unroll
            for (int m = 0; m < 4; ++m) { const int r = ai * HALF + wr * 64 + m * 16 + fr; const f32x2v sr = S[r]; const size_t off = (size_t)(u.pm * BM + r) * ldc + col0;
#pragma unroll
                for (int bj = 0; bj < 2; ++bj)
#pragma unroll
                    for (int n = 0; n < 2; ++n) { const f32x4 x1 = acc[ai][bj][m][n]; *(f32x4*)(out + off + bj * HALF + n * 16) = bad1 ? (f32x4){qnan, qnan, qnan, qnan} : x1;
                        const f32x4 o = (x1 - sr.x) * sr.y; u32x2v w; w.x = cvt_pk_bf16(o[0], o[1]); w.y = cvt_pk_bf16(o[2], o[3]);
                        if (bad) { w.x = 0x7fc07fc0u; w.y = 0x7fc07fc0u; } *(u32x2v*)(xn + off + bj * HALF + n * 16) = w; }
                asm volatile("" ::: "memory"); }
    }
};

template <class Epi, class Sched, bool ALIGN_EPI = false, bool SP2 = false>
__device__ __forceinline__ void gemm_phase(PG8_LAS unsigned char* lds, const Gemm g, const Sched& S, const Epi& E) {
    const int tid = threadIdx.x, wid = __builtin_amdgcn_readfirstlane(tid >> 6), lane = tid & 63, wr = wid >> 2, wc = wid & 3, fr = lane & 15, fq = lane >> 4;
    const int K = g.K, nt = K / BK;
    unsigned voffA[2], voffB[2];
#pragma unroll
    for (int i = 0; i < 2; ++i) { int R, C; stage_rc(tid * 16 + i * 8192, R, C); const int Rb = Epi::PERM ? ((R & ~31) + perm32(R & 31)) : R;
        voffA[i] = (unsigned)(R * K + C) * 2u; voffB[i] = (unsigned)(Rb * K + C) * 2u; }
    const size_t kstep = (size_t)(BK * 2);
    const size_t hstep = (size_t)HALF * K * 2;
    const size_t tstep = 2 * hstep;
    const unsigned ldsw = (unsigned)wid * 1024u;
    const int aoff = lds_byte(wr * 64 + fr, fq * 8), boff = lds_byte(wc * 32 + fr, fq * 8);
#define PG8_SA(b, h) (((b) * 2 + (h)) * HTB)
#define PG8_SB(b, h) ((4 + (b) * 2 + (h)) * HTB)
#define PG8_STAGE(bufoff, gbase, voff) do { _Pragma("unroll") for (int _i = 0; _i < 2; ++_i) \
        __builtin_amdgcn_global_load_lds((const unsigned*)((const char*)(gbase) + (voff)[_i]), (PG8_LAS unsigned*)(lds + (bufoff) + ldsw + _i * 8192), 16, 0, 0); } while (0)
#define PG8_LDA(dst, b, h) do { _Pragma("unroll") for (int m = 0; m < 4; ++m) _Pragma("unroll") for (int k = 0; k < 2; ++k) dst[m][k] = *(const PG8_LAS bf16x8*)(lds + PG8_SA(b, h) + aoff + m * 2048 + k * 1024); } while (0)
#define PG8_LDB(dst, b, h) do { _Pragma("unroll") for (int n = 0; n < 2; ++n) _Pragma("unroll") for (int k = 0; k < 2; ++k) dst[n][k] = *(const PG8_LAS bf16x8*)(lds + PG8_SB(b, h) + boff + n * 2048 + k * 1024); } while (0)
#define PG8_MMA(ai, bj, At, Bt) do { __builtin_amdgcn_s_setprio(1); _Pragma("unroll") for (int m = 0; m < 4; ++m) _Pragma("unroll") for (int n = 0; n < 2; ++n) _Pragma("unroll") for (int k = 0; k < 2; ++k) \
        acc[ai][bj][m][n] = __builtin_amdgcn_mfma_f32_16x16x32_bf16(Bt[n][k], At[m][k], acc[ai][bj][m][n], 0, 0, 0); __builtin_amdgcn_s_setprio(0); } while (0)
#define PG8_WAIT_V(n) asm volatile("s_waitcnt vmcnt(" #n ")" ::: "memory")
#define PG8_WAIT_L(n) asm volatile("s_waitcnt lgkmcnt(" #n ")" ::: "memory")
#define PG8_BAR __builtin_amdgcn_s_barrier()
#define PG8_SCHED __builtin_amdgcn_sched_barrier(0)
    Unit cur, nxt; int ui = 0;
    if (!S.next(0, cur)) return;
    f32x4 acc[2][2][4][2];
#pragma unroll
    for (int a = 0; a < 2; ++a)
#pragma unroll
        for (int b = 0; b < 2; ++b)
#pragma unroll
            for (int m = 0; m < 4; ++m)
#pragma unroll
                for (int n = 0; n < 2; ++n) acc[a][b][m][n] = (f32x4){0.f, 0.f, 0.f, 0.f};
    bf16x8 At[4][2], B0[2][2], B1[2][2];
    const char* cA = (const char*)g.A + (size_t)cur.pm * tstep; const char* cB = (const char*)g.Bt + (size_t)cur.pn * tstep;
    S.a_ready(cur);
    if constexpr (SP2) {
        PG8_STAGE(PG8_SB(0, 0), cB, voffB); PG8_STAGE(PG8_SB(0, 1), cB + hstep, voffB); PG8_STAGE(PG8_SA(0, 0), cA, voffA); PG8_STAGE(PG8_SA(0, 1), cA + hstep, voffA);
        if (wr == 1) PG8_BAR;
        PG8_WAIT_V(2); PG8_BAR;
        PG8_STAGE(PG8_SB(1, 0), cB + kstep, voffB); PG8_STAGE(PG8_SA(1, 0), cA + kstep, voffA); PG8_STAGE(PG8_SB(1, 1), cB + hstep + kstep, voffB);
        PG8_WAIT_V(6); PG8_BAR;
    } else {
        PG8_STAGE(PG8_SB(0, 0), cB, voffB); PG8_STAGE(PG8_SA(0, 0), cA, voffA); PG8_STAGE(PG8_SB(0, 1), cB + hstep, voffB); PG8_STAGE(PG8_SA(0, 1), cA + hstep, voffA);
        if (wr == 1) PG8_BAR;
        PG8_WAIT_V(4); PG8_BAR;
        PG8_STAGE(PG8_SB(1, 0), cB + kstep, voffB); PG8_STAGE(PG8_SA(1, 0), cA + kstep, voffA); PG8_STAGE(PG8_SB(1, 1), cB + hstep + kstep, voffB);
        PG8_WAIT_V(6); PG8_BAR;
    }
    for (;;) {
        const bool has_next = S.next(ui + 1, nxt);
        const char* nA = has_next ? (const char*)g.A + (size_t)nxt.pm * tstep : cA; const char* nB = has_next ? (const char*)g.Bt + (size_t)nxt.pn * tstep : cB;
        for (int t = 0; t < nt; t += 2) {
            const bool last = (t == nt - 2);
            const char* a1 = cA + (size_t)(t + 1) * kstep;
            const char* a2 = last ? nA : cA + (size_t)(t + 2) * kstep; const char* b2 = last ? nB : cB + (size_t)(t + 2) * kstep;
            const char* a3 = a2 + kstep; const char* b3 = b2 + kstep;
            if (last && has_next) S.a_ready(nxt);
            if constexpr (SP2) {
            PG8_LDB(B0, 0, 0); PG8_LDB(B1, 0, 1); PG8_SCHED; PG8_LDA(At, 0, 0); PG8_STAGE(PG8_SA(1, 1), a1 + hstep, voffA);
            PG8_WAIT_V(8); PG8_WAIT_L(0); PG8_BAR; PG8_MMA(0, 0, At, B0); PG8_MMA(0, 1, At, B1); PG8_BAR; PG8_SCHED;
            PG8_LDA(At, 0, 1); PG8_STAGE(PG8_SB(0, 0), b2, voffB); PG8_STAGE(PG8_SB(0, 1), b2 + hstep, voffB); PG8_STAGE(PG8_SA(0, 0), a2, voffA);
            PG8_WAIT_V(8); PG8_WAIT_L(0); PG8_BAR; PG8_MMA(1, 0, At, B0); PG8_MMA(1, 1, At, B1); PG8_BAR; PG8_SCHED;
            PG8_LDB(B0, 1, 0); PG8_LDB(B1, 1, 1); PG8_SCHED; PG8_LDA(At, 1, 0); PG8_STAGE(PG8_SA(0, 1), a2 + hstep, voffA);
            PG8_WAIT_V(8); PG8_WAIT_L(0); PG8_BAR; PG8_MMA(0, 0, At, B0); PG8_MMA(0, 1, At, B1); PG8_BAR; PG8_SCHED;
            PG8_LDA(At, 1, 1); PG8_STAGE(PG8_SB(1, 0), b3, voffB); PG8_STAGE(PG8_SB(1, 1), b3 + hstep, voffB); PG8_STAGE(PG8_SA(1, 0), a3, voffA);
            PG8_WAIT_V(8); PG8_WAIT_L(0); PG8_BAR; PG8_MMA(1, 0, At, B0); PG8_MMA(1, 1, At, B1); PG8_BAR; PG8_SCHED;
            } else {
            PG8_LDB(B0, 0, 0); PG8_SCHED; PG8_LDA(At, 0, 0); PG8_STAGE(PG8_SA(1, 1), a1 + hstep, voffA);
            PG8_WAIT_L(8); PG8_BAR; PG8_WAIT_L(0); PG8_MMA(0, 0, At, B0); PG8_BAR; PG8_SCHED;
            PG8_LDB(B1, 0, 1); PG8_STAGE(PG8_SB(0, 0), b2, voffB);
            PG8_BAR; PG8_WAIT_L(0); PG8_MMA(0, 1, At, B1); PG8_BAR;
            PG8_LDA(At, 0, 1); PG8_STAGE(PG8_SA(0, 0), a2, voffA);
            PG8_BAR; PG8_WAIT_L(0); PG8_MMA(1, 0, At, B0); PG8_BAR; PG8_SCHED;
            PG8_STAGE(PG8_SB(0, 1), b2 + hstep, voffB);
            PG8_WAIT_V(6); PG8_BAR; PG8_MMA(1, 1, At, B1); PG8_BAR;
            PG8_LDB(B0, 1, 0); PG8_SCHED; PG8_LDA(At, 1, 0); PG8_STAGE(PG8_SA(0, 1), a2 + hstep, voffA);
            PG8_WAIT_L(8); PG8_BAR; PG8_WAIT_L(0); PG8_MMA(0, 0, At, B0); PG8_BAR; PG8_SCHED;
            PG8_LDB(B1, 1, 1); PG8_STAGE(PG8_SB(1, 0), b3, voffB);
            PG8_BAR; PG8_WAIT_L(0); PG8_MMA(0, 1, At, B1); PG8_BAR;
            PG8_LDA(At, 1, 1); PG8_STAGE(PG8_SA(1, 0), a3, voffA);
            PG8_BAR; PG8_WAIT_L(0); PG8_MMA(1, 0, At, B0); PG8_BAR; PG8_SCHED;
            PG8_STAGE(PG8_SB(1, 1), b3 + hstep, voffB);
            PG8_WAIT_V(6); PG8_BAR; PG8_MMA(1, 1, At, B1); PG8_BAR;
            }
        }
        if constexpr (ALIGN_EPI) { if (wr == 0) PG8_BAR; }
        if constexpr (!Epi::AFTER_DRAIN) { E(acc, cur, wr, wc, fr, fq); S.done(cur); }
        if (!has_next) break;
#pragma unroll
        for (int a = 0; a < 2; ++a)
#pragma unroll
            for (int b = 0; b < 2; ++b)
#pragma unroll
                for (int m = 0; m < 4; ++m)
#pragma unroll
                    for (int n = 0; n < 2; ++n) acc[a][b][m][n] = (f32x4){0.f, 0.f, 0.f, 0.f};
        cur = nxt; cA = nA; cB = nB; ++ui;
        if constexpr (ALIGN_EPI) { if (wr == 1) PG8_BAR; }
    }
    PG8_WAIT_V(0);
    if constexpr (!ALIGN_EPI) { if (wr == 0) PG8_BAR; }
    PG8_BAR;
    if constexpr (Epi::AFTER_DRAIN) { E.fused(acc, cur, wr, wc, fr, fq, lds, wid, lane); S.done(cur); }
#undef PG8_SA
#undef PG8_SB
#undef PG8_STAGE
#undef PG8_LDA
#undef PG8_LDB
#undef PG8_MMA
#undef PG8_WAIT_V
#undef PG8_WAIT_L
#undef PG8_BAR
#undef PG8_SCHED
}
}
namespace pg8 {
struct EpiF32 {
    static constexpr bool PERM = false, AFTER_DRAIN = false;
    float* C; int ldc; const float* bias;
    __device__ __forceinline__ void operator()(const f32x4 (&acc)[2][2][4][2], const Unit& u, int wr, int wc, int fr, int fq) const {
        const int row0 = u.pm * BM + wr * 64 + fr, col0 = u.pn * BM + wc * 32 + 4 * fq;
        f32x4 bv[2][2];
#pragma unroll
        for (int bj = 0; bj < 2; ++bj)
#pragma unroll
            for (int n = 0; n < 2; ++n) bv[bj][n] = bias ? *(const f32x4*)(bias + col0 + bj * HALF + n * 16) : (f32x4){0.f, 0.f, 0.f, 0.f};
#pragma unroll
        for (int ai = 0; ai < 2; ++ai)
#pragma unroll
            for (int m = 0; m < 4; ++m) { float* rowp = C + (size_t)(row0 + ai * HALF + m * 16) * ldc + col0;
#pragma unroll
                for (int bj = 0; bj < 2; ++bj)
#pragma unroll
                    for (int n = 0; n < 2; ++n) *(f32x4*)(rowp + bj * HALF + n * 16) = acc[ai][bj][m][n] + bv[bj][n]; }
    }
};
}
#ifndef PG8_SP2
#define PG8_SP2 true
#endif
#ifndef PG8_ALIGN
#define PG8_ALIGN true
#endif
#define GAS __attribute__((address_space(1)))
#define LAS __attribute__((address_space(3)))
typedef unsigned short bf16;
typedef unsigned v4u __attribute__((ext_vector_type(4)));
typedef float f32x4 __attribute__((ext_vector_type(4)));
typedef short bf16x8 __attribute__((ext_vector_type(8)));
typedef GAS unsigned gu32;
typedef GAS unsigned long long gu64;
#define RLX_AGENT __ATOMIC_RELAXED, __HIP_MEMORY_SCOPE_AGENT
#define LDS_WAIT() asm volatile("s_waitcnt lgkmcnt(0)" ::: "memory")
#define VM_WAIT() asm volatile("s_waitcnt vmcnt(0)" ::: "memory")
__device__ __forceinline__ unsigned long long rt() { return __builtin_amdgcn_s_memrealtime(); }
__device__ __forceinline__ unsigned f2bf(float f) { unsigned u = __builtin_bit_cast(unsigned, f); return (u + 0x7fffu + ((u >> 16) & 1u)) >> 16; }
__device__ __forceinline__ unsigned pk2(float lo, float hi) { return f2bf(lo) | (f2bf(hi) << 16); }

#define XB_TMO      128
#define XB_XCNT(j)  (256  + 64 * (j))
#define XB_XSUB(j)  (1280 + 64 * (j))
#define XB_XGEN(j)  (2304 + 64 * (j))
#define XB_TOP      3328
#define XB_TOPGEN   3392
#define XCD_BAR_WORDS 3456
#define XB_SPIN_CAP (1u << 18)

__device__ __forceinline__ unsigned xb_ld(unsigned* p)              { return __hip_atomic_load(p, __ATOMIC_RELAXED, __HIP_MEMORY_SCOPE_AGENT); }
__device__ __forceinline__ unsigned xb_add(unsigned* p, unsigned v) { return __hip_atomic_fetch_add(p, v, __ATOMIC_RELAXED, __HIP_MEMORY_SCOPE_AGENT); }
__device__ __forceinline__ unsigned xb_xcc_id() { return (unsigned)__builtin_amdgcn_s_getreg((3 << 11) | 20) & 0xFu; }
#define XB_SPIN(cond, bar) do { unsigned _sp = 0; while (cond) { __builtin_amdgcn_s_sleep(1); \
    if ((++_sp & 255u) == 0u) { if (xb_ld(&(bar)[XB_TMO])) break; if (_sp > XB_SPIN_CAP) { atomicAdd(&(bar)[XB_TMO], 1u); break; } } } } while (0)

struct XcdBarrier {
    unsigned* bar; unsigned x;
    volatile LAS unsigned* st;
};

__device__ __forceinline__ XcdBarrier xcd_barrier_post(unsigned* bar, volatile LAS unsigned* st) {
    XcdBarrier b; b.bar = bar; b.x = xb_xcc_id(); b.st = st;
    if (threadIdx.x == 0) (void)xb_add(&bar[XB_XCNT(b.x)], 1u);
    return b;
}
__device__ __forceinline__ void xcd_barrier_complete(unsigned* bar, unsigned x, unsigned& nloc, unsigned& nx) {
    const unsigned G = gridDim.x * gridDim.y * gridDim.z;
    unsigned sum, cnt, mine, sp = 0u;
    for (;;) {
        sum = 0u; cnt = 0u; mine = 0u;
#pragma unroll
        for (unsigned j = 0; j < 16; ++j) { const unsigned c = xb_ld(&bar[XB_XCNT(j)]); sum += c; cnt += (c > 0u) ? 1u : 0u; mine = (j == x) ? c : mine; }
        if (sum == G) break;
        __builtin_amdgcn_s_sleep(1);
        if ((++sp & 255u) == 0u) { if (xb_ld(&bar[XB_TMO])) break; if (sp > XB_SPIN_CAP) { atomicAdd(&bar[XB_TMO], 1u); break; } }
    }
    nloc = mine > 0u ? mine : 1u; nx = cnt > 0u ? cnt : 1u;
}

__device__ __forceinline__ void xcd_barrier(const XcdBarrier& b) {
    asm volatile("s_waitcnt vmcnt(0)" ::: "memory");
    __syncthreads();
    if (threadIdx.x == 0) {
        unsigned* bar = b.bar;
        __builtin_amdgcn_s_waitcnt(0);
        unsigned nloc = b.st[0], nx = b.st[1];
        if (nloc == 0u) { xcd_barrier_complete(bar, b.x, nloc, nx); b.st[0] = nloc; b.st[1] = nx; }
        const unsigned old = xb_add(&bar[XB_XSUB(b.x)], 1u);
        const unsigned gen = old / nloc;
        if (old + 1u == (gen + 1u) * nloc) {
            __builtin_amdgcn_fence(__ATOMIC_RELEASE, "agent");
            asm volatile("s_waitcnt vmcnt(0)" ::: "memory");
            const unsigned og = xb_add(&bar[XB_TOP], 1u);
            const unsigned tg = og / nx;
            if (og + 1u == (tg + 1u) * nx) xb_add(&bar[XB_TOPGEN], 1u);
            else XB_SPIN(xb_ld(&bar[XB_TOPGEN]) == tg, bar);
            __builtin_amdgcn_fence(__ATOMIC_ACQUIRE, "agent");
            xb_add(&bar[XB_XGEN(b.x)], 1u);
            asm volatile("s_waitcnt vmcnt(0)" ::: "memory");
        } else {
            XB_SPIN(xb_ld(&bar[XB_XGEN(b.x)]) == gen, bar);
            __builtin_amdgcn_fence(__ATOMIC_ACQUIRE, "agent");
            asm volatile("s_waitcnt vmcnt(0)" ::: "memory");
        }
    }
    __syncthreads();
}

constexpr int D = 1024, NB = 2, T = 8192, MP = NB * T, DB = 128, MR = MP + DB  , MT = 16640  ;
constexpr int NH = 8, HD = 64, AW = 512, PW = 512, INW = 2048, FF = 2816, FF2 = 5632;
constexpr int NPAGES = 16, PSTATE = 15, NBLK_P = 32, NBLK_D = 8;
constexpr float RMS_EPS = 1e-6f;
constexpr int NWAVES = 8, NTHREADS = 512;

constexpr size_t O_YP = 0, O_YS = O_YP + (size_t)MP * D, O_KP = O_YS + (size_t)DB * D, O_VP = O_KP + (size_t)MP * AW, O_PP = O_VP + (size_t)MP * AW,
                 O_CP = O_PP + (size_t)NB * PSTATE * PW, O_KS = O_CP + (size_t)NB * 2 * FF2, O_VS = O_KS + (size_t)DB * AW, O_PS = O_VS + (size_t)DB * AW,
                 O_CS = O_PS + (size_t)DB * PSTATE * PW, O_END = O_CS + (size_t)DB * 2 * FF2;
static_assert(O_END == 36279296, "output size");

constexpr size_t MiB = 1u << 20;
constexpr size_t WS_CTL = 0, CTL_ZERO_BYTES = 1 * MiB;
constexpr size_t WS_WIN = 2 * MiB, WS_WO2 = 6 * MiB, WS_WUP = 8 * MiB, WS_WDN = 19 * MiB, WS_MOD = 25 * MiB, WS_ROPE = 29 * MiB, WS_KMD = 31 * MiB, WS_KMP = 33 * MiB;
constexpr size_t WS_XN = 34 * MiB, WS_PROJ = 67 * MiB, WS_QF = 197 * MiB, WS_A2 = 230 * MiB, WS_MIX = 263 * MiB, WS_X1 = 328 * MiB, WS_UP = 393 * MiB, WS_ACT = 751 * MiB, WS_FFN = 841 * MiB, WS_END = 906 * MiB;
static_assert(WS_WIN + (size_t)INW * D * 2 <= WS_WO2 && WS_WO2 + (size_t)D * D * 2 <= WS_WUP && WS_WUP + (size_t)FF2 * D * 2 <= WS_WDN && WS_WDN + (size_t)D * FF * 2 <= WS_MOD, "ws map 1");
static_assert(WS_MOD + (size_t)130 * 6 * D * 4 <= WS_ROPE && WS_ROPE + (size_t)T * 32 * 8 <= WS_KMD && WS_KMD + (size_t)DB * NBLK_D * AW * 4 <= WS_KMP && WS_KMP + (size_t)NB * NBLK_P * AW * 4 <= WS_XN, "ws map 2");
static_assert(WS_XN + (size_t)MT * D * 2 <= WS_PROJ && WS_PROJ + (size_t)MT * INW * 4 <= WS_QF && WS_QF + (size_t)MT * AW * 4 <= WS_A2 && WS_A2 + (size_t)MT * D * 2 <= WS_MIX, "ws map 3");
static_assert(WS_MIX + (size_t)MT * D * 4 <= WS_X1 && WS_X1 + (size_t)MT * D * 4 <= WS_UP && WS_UP + (size_t)MT * FF2 * 4 <= WS_ACT && WS_ACT + (size_t)MT * FF * 2 <= WS_FFN && WS_FFN + (size_t)MT * D * 4 <= WS_END, "ws map 4");
constexpr int CW_BAR = 4096;

constexpr int LDS_BYTES = 147456;
constexpr int MISC_OFF = 131072 + 320;

__device__ const double ROPE_INV[32] = {
1.00000000000000000000e+00, 7.49894209332455874417e-01, 5.62341325190349072827e-01, 4.21696503428582225581e-01, 3.16227766016837941176e-01, 2.37137370566165517349e-01, 1.77827941003892292526e-01, 1.33352143216332402753e-01,
1.00000000000000005551e-01, 7.49894209332455791150e-02, 5.62341325190349114460e-02, 4.21696503428582239459e-02, 3.16227766016837913421e-02, 2.37137370566165538166e-02, 1.77827941003892292526e-02, 1.33352143216332406223e-02,
1.00000000000000002082e-02, 7.49894209332455791150e-03, 5.62341325190349097113e-03, 4.21696503428582291501e-03, 3.16227766016837939442e-03, 2.37137370566165538166e-03, 1.77827941003892275179e-03, 1.33352143216332406223e-03,
1.00000000000000002082e-03, 7.49894209332455856203e-04, 5.62341325190349097113e-04, 4.21696503428582237290e-04, 3.16227766016837939442e-04, 2.37137370566165538166e-04, 1.77827941003892269758e-04, 1.33352143216332395381e-04};

struct Args { const void* in[23]; float* out; unsigned char* ws; int ph_lo, ph_hi; };

struct Ctx {
    LAS unsigned char* lds;
    int tid, lane, wave, gw, NGW, G;
    const float *x_prompt, *x_sample, *c_prompt, *c_sample, *cache_k, *cache_v; const int* page_table; const float *state_pool, *state_conv;
    const float *w_ada, *b_ada, *g_mix_pre, *g_mix_post, *w_in, *pool_w, *pool_scale, *w_out, *g_ffn_pre, *g_ffn_post, *w_up, *conv_w, *conv_b, *w_down;
    float* out;
    bf16 *WIN, *WO2, *WUP, *WDN, *XN, *A2, *ACT; float *MOD, *KMD, *KMP, *PROJ, *QF, *MIX, *X1, *UP, *FFN; float2* ROPE;
};

__device__ __forceinline__ float wave_sum(float v) {
#pragma unroll
    for (int o = 1; o < 64; o <<= 1) v += __shfl_xor(v, o);
    return v;
}
__device__ __forceinline__ float wave_max(float v) {
#pragma unroll
    for (int o = 1; o < 64; o <<= 1) v = fmaxf(v, __shfl_xor(v, o));
    return v;
}
__device__ __forceinline__ float silu_f(float v) { return v / (1.0f + __expf(-v)); }

__device__ __forceinline__ void dsincos(double a, double& s, double& c) {
    const double k = __builtin_rint(a * 0.63661977236758134308);
    double r = __builtin_fma(-k, 1.57079632679489655800e+00, a);
    r = __builtin_fma(-k, 6.12323399573676603587e-17, r);
    const double r2 = r * r;
    double sp = 1.0 / 6227020800.0;
    sp = sp * r2 - 1.0 / 39916800.0; sp = sp * r2 + 1.0 / 362880.0; sp = sp * r2 - 1.0 / 5040.0; sp = sp * r2 + 1.0 / 120.0; sp = sp * r2 - 1.0 / 6.0;
    const double sn = r + r * r2 * sp;
    double cp = -1.0 / 87178291200.0;
    cp = cp * r2 + 1.0 / 479001600.0; cp = cp * r2 - 1.0 / 3628800.0; cp = cp * r2 + 1.0 / 40320.0; cp = cp * r2 - 1.0 / 720.0; cp = cp * r2 + 1.0 / 24.0; cp = cp * r2 - 0.5;
    const double cn = 1.0 + r2 * cp;
    const int q = ((int)k) & 3;
    s = (q == 0) ? sn : (q == 1) ? cn : (q == 2) ? -sn : -cn;
    c = (q == 0) ? cn : (q == 1) ? -sn : (q == 2) ? -cn : sn;
}

__device__ __forceinline__ void transpose_item(const float* W, int ldw, bf16* WT, int ldt, int koff, int nblk, LAS float* scr, int item, int lane) {
    const int kb = item / nblk, nb = item % nblk, k0 = 64 * kb, n0 = 32 * nb;
#pragma unroll 8
    for (int i = 0; i < 32; ++i) { const int kk = 2 * i + (lane >> 5); scr[kk * 33 + (lane & 31)] = W[(size_t)(k0 + kk) * ldw + n0 + (lane & 31)]; }
    LDS_WAIT(); asm volatile("" ::: "memory");
    const int c = lane & 7;
#pragma unroll
    for (int j = 0; j < 4; ++j) { const int n = (lane >> 3) + 8 * j; const LAS float* s = scr + (8 * c) * 33 + n;
        v4u o; o.x = pk2(s[0 * 33], s[1 * 33]); o.y = pk2(s[2 * 33], s[3 * 33]); o.z = pk2(s[4 * 33], s[5 * 33]); o.w = pk2(s[6 * 33], s[7 * 33]);
        *(GAS v4u*)(WT + (size_t)(n0 + n) * ldt + koff + k0 + 8 * c) = o; }
    LDS_WAIT(); asm volatile("" ::: "memory");
}

__device__ __forceinline__ void p0_prologue(Ctx& F) {
    {
        LAS float* sl = (LAS float*)F.lds;
        for (int item = blockIdx.x; item < 120; item += F.G) {
            const int nch = item % 12, rg = item / 12;
            __syncthreads();
            for (int e = F.tid; e < 13 * D; e += NTHREADS) { const int rr = e >> 10, k = e & 1023, row = rg * 13 + rr;
                const float cv = (row < 2) ? F.c_prompt[row * D + k] : F.c_sample[(row - 2) * D + k]; sl[e] = silu_f(cv); }
            __syncthreads();
            const int n = nch * 512 + F.tid;
            float acc[13];
#pragma unroll
            for (int rr = 0; rr < 13; ++rr) acc[rr] = 0.f;
            for (int k = 0; k < D; ++k) { const float w = F.w_ada[(size_t)k * (6 * D) + n];
#pragma unroll
                for (int rr = 0; rr < 13; ++rr) acc[rr] += sl[rr * D + k] * w; }
            const float bv = F.b_ada[n];
#pragma unroll
            for (int rr = 0; rr < 13; ++rr) F.MOD[(size_t)(rg * 13 + rr) * (6 * D) + n] = acc[rr] + bv;
        }
        __syncthreads();
    }
    {
        LAS float* scr = (LAS float*)(F.lds + F.wave * 16384);
        constexpr int I_IN = (D / 64) * (INW / 32), I_O = (512 / 64) * (D / 32), I_UP = (D / 64) * (FF2 / 32), I_DN = (FF / 64) * (D / 32);
        constexpr int NITEMS = I_IN + I_O + I_UP + I_DN;
        for (int it = F.gw; it < NITEMS; it += F.NGW) {
            int r = it;
            if (r < I_IN) { transpose_item(F.w_in, INW, F.WIN, D, 0, INW / 32, scr, r, F.lane); continue; } r -= I_IN;
            if (r < I_O) { transpose_item(F.w_out + (size_t)512 * D, D, F.WO2, D, 512, D / 32, scr, r, F.lane); continue; } r -= I_O;
            if (r < I_UP) { transpose_item(F.w_up, FF2, F.WUP, D, 0, FF2 / 32, scr, r, F.lane); continue; } r -= I_UP;
            transpose_item(F.w_down, D, F.WDN, FF, 0, D / 32, scr, r, F.lane);
        }
    }
    for (int it = F.gw; it < D * 8; it += F.NGW) {
        const int n = it >> 3, kch = it & 7, k = kch * 64 + F.lane, g = k >> 7;
        const float* pw = F.pool_w + (size_t)k * 128;
        float acc = 0.f;
        for (int d = 0; d < 128; ++d) acc += pw[d] * (F.pool_scale[g * 128 + d] * F.w_out[(size_t)(g * 128 + d) * D + n]);
        F.WO2[(size_t)n * D + k] = (bf16)f2bf(acc);
    }
    for (int e = blockIdx.x * NTHREADS + F.tid; e < T * 32; e += F.G * NTHREADS) {
        const int pos = e >> 5, i = e & 31; double s, c; dsincos((double)pos * ROPE_INV[i], s, c);
        F.ROPE[e] = make_float2((float)c, (float)s);
    }
    {
        LAS f32x4* red = (LAS f32x4*)F.lds;
        const int ts = F.tid >> 7, c4 = F.tid & 127;
        for (int item = blockIdx.x; item < DB * NBLK_D; item += F.G) {
            const int b = item >> 3, n = item & 7;
            const int pg0 = F.page_table[b * NPAGES + 2 * n], pg1 = F.page_table[b * NPAGES + 2 * n + 1];
            f32x4 acc = (f32x4){0.f, 0.f, 0.f, 0.f};
#pragma unroll 8
            for (int itk = 0; itk < 64; ++itk) { const int tok = itk * 4 + ts; const int pg = (tok < 128) ? pg0 : pg1;
                acc += *(const f32x4*)(F.cache_k + ((size_t)pg * 128 + (tok & 127)) * AW + c4 * 4); }
            __syncthreads();
            red[ts * 128 + c4] = acc;
            __syncthreads();
            if (F.tid < 128) { const f32x4 s = (red[c4] + red[128 + c4]) + (red[256 + c4] + red[384 + c4]);
                *(f32x4*)(F.KMD + (size_t)item * AW + c4 * 4) = s * (1.0f / 256.0f); }
        }
        __syncthreads();
    }
}

__device__ __forceinline__ const float* x_row(const Ctx& F, int r) { return (r < MP) ? F.x_prompt + (size_t)r * D : F.x_sample + (size_t)(r - MP) * D; }
__device__ __forceinline__ int mod_row(int r) { return (r < MP) ? (r >> 13) : 2 + (r - MP); }

__device__ __forceinline__ void p1_norm_in(Ctx& F) {
    for (int r = F.gw; r < MT; r += F.NGW) {
        GAS unsigned long long* o8 = (GAS unsigned long long*)(F.XN + (size_t)r * D) + F.lane;
        if (r >= MR) {
#pragma unroll
            for (int j = 0; j < 4; ++j) o8[64 * j] = 0ull;
            GAS unsigned long long* a8 = (GAS unsigned long long*)(F.A2 + (size_t)r * D) + F.lane;
#pragma unroll
            for (int j = 0; j < 4; ++j) a8[64 * j] = 0ull;
            GAS unsigned long long* c8 = (GAS unsigned long long*)(F.ACT + (size_t)r * FF) + F.lane;
            for (int j = 0; j < FF / 256; ++j) c8[64 * j] = 0ull;
            continue;
        }
        const f32x4* xr = (const f32x4*)x_row(F, r) + F.lane;
        const float* mod = F.MOD + (size_t)mod_row(r) * (6 * D);
        f32x4 v[4]; float ss = 0.f;
#pragma unroll
        for (int j = 0; j < 4; ++j) { v[j] = xr[64 * j]; ss += (v[j].x * v[j].x + v[j].y * v[j].y) + (v[j].z * v[j].z + v[j].w * v[j].w); }
        const float rs = 1.0f / sqrtf(wave_sum(ss) * (1.0f / D) + RMS_EPS);
#pragma unroll
        for (int j = 0; j < 4; ++j) { const int c = 4 * F.lane + 256 * j;
            const f32x4 g = *(const f32x4*)(F.g_mix_pre + c), sh = *(const f32x4*)(mod + c), sc = *(const f32x4*)(mod + D + c);
            const f32x4 h = v[j] * rs * g * (sc + 1.0f) + sh;
            o8[64 * j] = (unsigned long long)pk2(h.x, h.y) | ((unsigned long long)pk2(h.z, h.w) << 32); }
    }
}

__device__ __forceinline__ void p3_post_proj(Ctx& F) {
    {
        LAS float* red = (LAS float*)F.lds;
        const int half = F.tid >> 8, pi = F.tid & 255, hh = pi >> 5, i = pi & 31, col = hh * 64 + i;
        for (int item = blockIdx.x; item < NB * NBLK_P; item += F.G) {
            const int bb = item >> 5, blk = item & 31;
            const int t0 = blk * 256 + half * 128; const size_t r0 = (size_t)bb * T + t0;
            float a1 = 0.f, a2 = 0.f;
#pragma unroll 4
            for (int rr = 0; rr < 128; ++rr) { const float* p = F.PROJ + (r0 + rr) * INW + 1024 + col; const float x1 = p[0], x2 = p[32];
                const float2 cs = F.ROPE[(t0 + rr) * 32 + i]; a1 += x1 * cs.x - x2 * cs.y; a2 += x2 * cs.x + x1 * cs.y; }
            __syncthreads();
            red[half * 512 + col] = a1; red[half * 512 + col + 32] = a2;
            __syncthreads();
            F.KMP[(size_t)item * AW + F.tid] = (red[F.tid] + red[512 + F.tid]) * (1.0f / 256.0f);
        }
        __syncthreads();
    }
    for (int r = F.gw; r < MR; r += F.NGW) {
        const bool dec = r >= MP; const int bb = dec ? (r - MP) : (r >> 13), t = dec ? 0 : (r & (T - 1)), pos = dec ? 2048 : t;
        const float* P = F.PROJ + (size_t)r * INW;
        float* kout = dec ? F.out + O_KS + (size_t)bb * AW : F.out + O_KP + (size_t)r * AW;
        float* vout = dec ? F.out + O_VS + (size_t)bb * AW : F.out + O_VP + (size_t)r * AW;
        float* qout = F.QF + (size_t)r * AW;
#pragma unroll
        for (int j = 0; j < 4; ++j) { const int pi = F.lane + 64 * j, hh = pi >> 5, i = pi & 31, col = hh * 64 + i;
            const float2 cs = F.ROPE[pos * 32 + i];
            const float q1 = P[512 + col], q2 = P[512 + col + 32], k1 = P[1024 + col], k2 = P[1024 + col + 32];
            qout[col] = q1 * cs.x - q2 * cs.y; qout[col + 32] = q2 * cs.x + q1 * cs.y;
            kout[col] = k1 * cs.x - k2 * cs.y; kout[col + 32] = k2 * cs.x + k1 * cs.y; }
#pragma unroll
        for (int j = 0; j < 2; ++j) *(f32x4*)(vout + (F.lane + 64 * j) * 4) = *(const f32x4*)(P + 1536 + (F.lane + 64 * j) * 4);
        const int c = F.lane * 8, g = c >> 7, w = 2 << g;
        const f32x4 u0 = *(const f32x4*)(P + c), u1 = *(const f32x4*)(P + c + 4);
        f32x4 s0 = u0, s1 = u1; int nterms;
        if (!dec) {
            nterms = (t + 1 < w) ? t + 1 : w;
            for (int s = 1; s < 16; ++s) if (s < nterms) { const float* pp = P - (size_t)s * INW + c; s0 += *(const f32x4*)pp; s1 += *(const f32x4*)(pp + 4); }
            if (t >= T - PSTATE) { float* po = F.out + O_PP + ((size_t)bb * PSTATE + (t - (T - PSTATE))) * PW + c; *(f32x4*)po = u0; *(f32x4*)(po + 4) = u1; }
        } else {
            nterms = w;
            const float* sp = F.state_pool + (size_t)bb * PSTATE * PW + c;
            for (int s = 1; s < 16; ++s) if (s < w) { const float* pp = sp + (size_t)(PSTATE - s) * PW; s0 += *(const f32x4*)pp; s1 += *(const f32x4*)(pp + 4); }
            float* po = F.out + O_PS + (size_t)bb * PSTATE * PW + c;
            for (int j = 0; j < PSTATE - 1; ++j) { *(f32x4*)(po + (size_t)j * PW) = *(const f32x4*)(sp + (size_t)(j + 1) * PW); *(f32x4*)(po + (size_t)j * PW + 4) = *(const f32x4*)(sp + (size_t)(j + 1) * PW + 4); }
            *(f32x4*)(po + (size_t)(PSTATE - 1) * PW) = u0; *(f32x4*)(po + (size_t)(PSTATE - 1) * PW + 4) = u1;
        }
        const float inv = 1.0f / (float)nterms;
        const f32x4 p0 = s0 * inv - u0, p1 = s1 * inv - u1;
        v4u o; o.x = pk2(p0.x, p0.y); o.y = pk2(p0.z, p0.w); o.z = pk2(p1.x, p1.y); o.w = pk2(p1.z, p1.w);
        *(GAS v4u*)(F.A2 + (size_t)r * D + c) = o;
    }
}

__device__ __forceinline__ void p4_attention_naive(Ctx& F) {
    LAS float* qs = (LAS float*)(F.lds + F.wave * 8192);
    LAS float* S = qs + 64;
    const float* Kf = F.out + O_KP; const float* Vf = F.out + O_VP;
    const int NITEM = MP * NH + DB * NH;
    for (int idx = F.gw; idx < NITEM; idx += F.NGW) {
        const bool dec = idx >= MP * NH;
        const int r = dec ? MP + ((idx - MP * NH) >> 3) : (idx >> 3), hh = idx & 7;
        const int bb = dec ? (r - MP) : (r >> 13), t = dec ? 2048 : (r & (T - 1)), own = t >> 8;
        LDS_WAIT(); asm volatile("" ::: "memory");
        qs[F.lane] = F.QF[(size_t)r * AW + hh * HD + F.lane];
        LDS_WAIT(); asm volatile("" ::: "memory");
        float gate = -INFINITY;
        if (F.lane < own) {
            const float* km = dec ? F.KMD + ((size_t)bb * NBLK_D + F.lane) * AW + hh * HD : F.KMP + ((size_t)bb * NBLK_P + F.lane) * AW + hh * HD;
            float acc = 0.f;
            for (int d = 0; d < HD; ++d) acc += qs[d] * km[d];
            gate = acc;
        }
        int sel0 = 0, sel1 = 0, sel2 = 0, nsel = 0;
#pragma unroll
        for (int k = 0; k < 3; ++k) {
            const float m = wave_max(gate);
            if (m != -INFINITY) {
                const unsigned long long bal = __ballot(gate == m);
                const int ix = __ffsll((long long)bal) - 1;
                if (k == 0) sel0 = ix; else if (k == 1) sel1 = ix; else sel2 = ix;
                nsel = k + 1;
                if (F.lane == ix) gate = -INFINITY;
            }
        }
        const int nblk = nsel + 1;
        float lmax = -INFINITY;
        for (int j = 0; j < nblk; ++j) {
            const int blk = (j < nsel) ? ((j == 0) ? sel0 : (j == 1) ? sel1 : sel2) : own;
            if (dec && j == nsel) {
                const float* kp = F.out + O_KS + (size_t)bb * AW + hh * HD;
                float acc = 0.f;
                for (int d = 0; d < HD; ++d) acc += qs[d] * kp[d];
                const float s = acc * 0.125f;
                if (F.lane == 0) S[j * 256] = s;
                lmax = fmaxf(lmax, s);
                continue;
            }
            for (int rr = 0; rr < 4; ++rr) {
                const int kk = rr * 64 + F.lane, key = blk * 256 + kk;
                const float* kp;
                if (dec) { const int pg = F.page_table[bb * NPAGES + 2 * blk + (kk >> 7)]; kp = F.cache_k + ((size_t)pg * 128 + (kk & 127)) * AW + hh * HD; }
                else kp = Kf + ((size_t)bb * T + key) * AW + hh * HD;
                float acc = 0.f;
#pragma unroll
                for (int d4 = 0; d4 < 16; ++d4) { const f32x4 kv = *(const f32x4*)(kp + 4 * d4); const f32x4 qv = *(const LAS f32x4*)(qs + 4 * d4);
                    acc += (kv.x * qv.x + kv.y * qv.y) + (kv.z * qv.z + kv.w * qv.w); }
                float s = acc * 0.125f;
                if (key > t) s = -INFINITY;
                S[j * 256 + kk] = s;
                lmax = fmaxf(lmax, s);
            }
        }
        const float m = wave_max(lmax);
        LDS_WAIT(); asm volatile("" ::: "memory");
        const int nkeys = (dec ? nsel * 256 + 1 : nblk * 256);
        float lsum = 0.f;
        for (int e = F.lane; e < nkeys; e += 64) { const float p = __expf(S[e] - m); S[e] = p; lsum += p; }
        const float l = wave_sum(lsum);
        LDS_WAIT(); asm volatile("" ::: "memory");
        float acc = 0.f;
        for (int j = 0; j < nblk; ++j) {
            const int blk = (j < nsel) ? ((j == 0) ? sel0 : (j == 1) ? sel1 : sel2) : own;
            if (dec && j == nsel) { acc += S[j * 256] * F.out[O_VS + (size_t)bb * AW + hh * HD + F.lane]; continue; }
            int kend = 256;
            if (!dec && j == nsel) kend = t - own * 256 + 1;
            if (dec) {
                const int pg0 = F.page_table[bb * NPAGES + 2 * blk], pg1 = F.page_table[bb * NPAGES + 2 * blk + 1];
                for (int kk = 0; kk < 256; ++kk) { const int pg = (kk < 128) ? pg0 : pg1;
                    acc += S[j * 256 + kk] * F.cache_v[((size_t)pg * 128 + (kk & 127)) * AW + hh * HD + F.lane]; }
            } else {
                const float* vp = Vf + ((size_t)bb * T + blk * 256) * AW + hh * HD + F.lane;
                for (int kk = 0; kk < kend; ++kk) acc += S[j * 256 + kk] * vp[(size_t)kk * AW];
            }
        }
        F.A2[(size_t)r * D + 512 + hh * HD + F.lane] = (bf16)f2bf(acc / l);
    }
}

__device__ __forceinline__ void p6_mid_norm(Ctx& F) {
    for (int r = F.gw; r < MR; r += F.NGW) {
        const f32x4* xr = (const f32x4*)x_row(F, r) + F.lane;
        const f32x4* mr = (const f32x4*)(F.MIX + (size_t)r * D) + F.lane;
        const float* mod = F.MOD + (size_t)mod_row(r) * (6 * D);
        f32x4 v[4]; float ss = 0.f;
#pragma unroll
        for (int j = 0; j < 4; ++j) { v[j] = mr[64 * j]; ss += (v[j].x * v[j].x + v[j].y * v[j].y) + (v[j].z * v[j].z + v[j].w * v[j].w); }
        const float rs = 1.0f / sqrtf(wave_sum(ss) * (1.0f / D) + RMS_EPS);
        float ss2 = 0.f;
#pragma unroll
        for (int j = 0; j < 4; ++j) { const int c = 4 * F.lane + 256 * j;
            const f32x4 g = *(const f32x4*)(F.g_mix_post + c), gt = *(const f32x4*)(mod + 2 * D + c);
            v[j] = xr[64 * j] + gt * (v[j] * rs * g);
            *((f32x4*)(F.X1 + (size_t)r * D) + F.lane + 64 * j) = v[j];
            ss2 += (v[j].x * v[j].x + v[j].y * v[j].y) + (v[j].z * v[j].z + v[j].w * v[j].w); }
        const float rs2 = 1.0f / sqrtf(wave_sum(ss2) * (1.0f / D) + RMS_EPS);
        GAS unsigned long long* o8 = (GAS unsigned long long*)(F.XN + (size_t)r * D) + F.lane;
#pragma unroll
        for (int j = 0; j < 4; ++j) { const int c = 4 * F.lane + 256 * j;
            const f32x4 g = *(const f32x4*)(F.g_ffn_pre + c), sh = *(const f32x4*)(mod + 3 * D + c), sc = *(const f32x4*)(mod + 4 * D + c);
            const f32x4 h = v[j] * rs2 * g * (sc + 1.0f) + sh;
            o8[64 * j] = (unsigned long long)pk2(h.x, h.y) | ((unsigned long long)pk2(h.z, h.w) << 32); }
    }
}

__device__ __forceinline__ void p8_conv_act(Ctx& F) {
    for (int r = blockIdx.x; r < MR; r += F.G) {
        const bool dec = r >= MP; const int bb = dec ? (r - MP) : (r >> 13), t = dec ? 0 : (r & (T - 1));
        const float* u2 = F.UP + (size_t)r * FF2;
        const float* u1; const float* u0; bool z1 = false, z0 = false;
        if (dec) { u0 = F.state_conv + (size_t)bb * 2 * FF2; u1 = u0 + FF2; }
        else { u1 = u2 - FF2; u0 = u2 - 2 * (size_t)FF2; z1 = (t < 1); z0 = (t < 2); }
        for (int j = F.tid; j < FF; j += NTHREADS) {
            const float a2 = u2[j], g2 = u2[j + FF];
            const float a1 = z1 ? 0.f : u1[j], g1 = z1 ? 0.f : u1[j + FF];
            const float a0 = z0 ? 0.f : u0[j], g0 = z0 ? 0.f : u0[j + FF];
            const float ca = F.conv_b[j] + F.conv_w[j] * a0 + F.conv_w[FF2 + j] * a1 + F.conv_w[2 * FF2 + j] * a2;
            const float cg = F.conv_b[j + FF] + F.conv_w[j + FF] * g0 + F.conv_w[FF2 + j + FF] * g1 + F.conv_w[2 * FF2 + j + FF] * g2;
            F.ACT[(size_t)r * FF + j] = (bf16)f2bf(silu_f(ca) * cg);
            if (dec) { float* o = F.out + O_CS + (size_t)bb * 2 * FF2; o[j] = a1; o[j + FF] = g1; o[FF2 + j] = a2; o[FF2 + j + FF] = g2; }
            else if (t >= T - 2) { float* o = F.out + O_CP + ((size_t)bb * 2 + (t - (T - 2))) * FF2; o[j] = a2; o[j + FF] = g2; }
        }
    }
}

__device__ __forceinline__ void p10_final(Ctx& F) {
    for (int r = F.gw; r < MR; r += F.NGW) {
        const f32x4* fr = (const f32x4*)(F.FFN + (size_t)r * D) + F.lane;
        const f32x4* x1 = (const f32x4*)(F.X1 + (size_t)r * D) + F.lane;
        const float* mod = F.MOD + (size_t)mod_row(r) * (6 * D);
        float* yo = (r < MP) ? F.out + O_YP + (size_t)r * D : F.out + O_YS + (size_t)(r - MP) * D;
        f32x4 v[4]; float ss = 0.f;
#pragma unroll
        for (int j = 0; j < 4; ++j) { v[j] = fr[64 * j]; ss += (v[j].x * v[j].x + v[j].y * v[j].y) + (v[j].z * v[j].z + v[j].w * v[j].w); }
        const float rs = 1.0f / sqrtf(wave_sum(ss) * (1.0f / D) + RMS_EPS);
#pragma unroll
        for (int j = 0; j < 4; ++j) { const int c = 4 * F.lane + 256 * j;
            const f32x4 g = *(const f32x4*)(F.g_ffn_post + c), gt = *(const f32x4*)(mod + 5 * D + c);
            *((f32x4*)yo + F.lane + 64 * j) = x1[64 * j] + gt * (v[j] * rs * g); }
    }
}

constexpr int N_PHASES = 11;
__global__ void __launch_bounds__(NTHREADS, 2) fwd(Args args) {
    extern __shared__ __attribute__((aligned(16))) unsigned char lds[];
    Ctx F;
    F.lds = (LAS unsigned char*)lds;
    F.tid = threadIdx.x; F.lane = F.tid & 63; F.wave = __builtin_amdgcn_readfirstlane(F.tid >> 6);
    F.G = gridDim.x; F.gw = blockIdx.x * NWAVES + F.wave; F.NGW = F.G * NWAVES;
    F.x_prompt = (const float*)args.in[0]; F.x_sample = (const float*)args.in[1]; F.c_prompt = (const float*)args.in[2]; F.c_sample = (const float*)args.in[3];
    F.cache_k = (const float*)args.in[4]; F.cache_v = (const float*)args.in[5]; F.page_table = (const int*)args.in[6]; F.state_pool = (const float*)args.in[7]; F.state_conv = (const float*)args.in[8];
    F.w_ada = (const float*)args.in[9]; F.b_ada = (const float*)args.in[10]; F.g_mix_pre = (const float*)args.in[11]; F.g_mix_post = (const float*)args.in[12]; F.w_in = (const float*)args.in[13];
    F.pool_w = (const float*)args.in[14]; F.pool_scale = (const float*)args.in[15]; F.w_out = (const float*)args.in[16]; F.g_ffn_pre = (const float*)args.in[17]; F.g_ffn_post = (const float*)args.in[18];
    F.w_up = (const float*)args.in[19]; F.conv_w = (const float*)args.in[20]; F.conv_b = (const float*)args.in[21]; F.w_down = (const float*)args.in[22];
    F.out = args.out;
    unsigned char* ws = args.ws;
    F.WIN = (bf16*)(ws + WS_WIN); F.WO2 = (bf16*)(ws + WS_WO2); F.WUP = (bf16*)(ws + WS_WUP); F.WDN = (bf16*)(ws + WS_WDN);
    F.MOD = (float*)(ws + WS_MOD); F.ROPE = (float2*)(ws + WS_ROPE); F.KMD = (float*)(ws + WS_KMD); F.KMP = (float*)(ws + WS_KMP);
    F.XN = (bf16*)(ws + WS_XN); F.PROJ = (float*)(ws + WS_PROJ); F.QF = (float*)(ws + WS_QF); F.A2 = (bf16*)(ws + WS_A2); F.MIX = (float*)(ws + WS_MIX);
    F.X1 = (float*)(ws + WS_X1); F.UP = (float*)(ws + WS_UP); F.ACT = (bf16*)(ws + WS_ACT); F.FFN = (float*)(ws + WS_FFN);

    volatile LAS unsigned* MISC = (volatile LAS unsigned*)(F.lds + MISC_OFF);
    for (int u = F.tid; u < (LDS_BYTES - 131072) / 4; u += NTHREADS) ((LAS unsigned*)(F.lds + 131072))[u] = 0u;
    __syncthreads();
    const int lo = args.ph_lo, hi = args.ph_hi;
    const bool multi = (hi - lo) > 1;
    XcdBarrier bar; bar.bar = (unsigned*)(ws + WS_CTL) + CW_BAR; bar.x = 0; bar.st = nullptr;
    if (multi) bar = xcd_barrier_post((unsigned*)(ws + WS_CTL) + CW_BAR, MISC + 8);
#define IN(k) (lo <= (k) && (k) < hi)
#define SEAM(k) do { if (IN(k) && IN((k) + 1)) xcd_barrier(bar); } while (0)

    if (IN(0)) { p0_prologue(F); } SEAM(0);
    if (IN(1)) { p1_norm_in(F); } SEAM(1);
    if (IN(2)) { pg8::Gemm g{F.XN, F.WIN, MT, INW, D}; pg8::StaticOrder S; S.init(MT, INW, F.G, (int)blockIdx.x); pg8::EpiF32 E{F.PROJ, INW, nullptr};
        pg8::gemm_phase<pg8::EpiF32, pg8::StaticOrder, PG8_ALIGN, PG8_SP2>(F.lds, g, S, E); } SEAM(2);
    if (IN(3)) { p3_post_proj(F); } SEAM(3);
    if (IN(4)) { p4_attention_naive(F); } SEAM(4);
    if (IN(5)) { pg8::Gemm g{F.A2, F.WO2, MT, D, D}; pg8::StaticOrder S; S.init(MT, D, F.G, (int)blockIdx.x); pg8::EpiF32 E{F.MIX, D, nullptr};
        pg8::gemm_phase<pg8::EpiF32, pg8::StaticOrder, PG8_ALIGN, PG8_SP2>(F.lds, g, S, E); } SEAM(5);
    if (IN(6)) { p6_mid_norm(F); } SEAM(6);
    if (IN(7)) { pg8::Gemm g{F.XN, F.WUP, MT, FF2, D}; pg8::StaticOrder S; S.init(MT, FF2, F.G, (int)blockIdx.x); pg8::EpiF32 E{F.UP, FF2, nullptr};
        pg8::gemm_phase<pg8::EpiF32, pg8::StaticOrder, PG8_ALIGN, PG8_SP2>(F.lds, g, S, E); } SEAM(7);
    if (IN(8)) { p8_conv_act(F); } SEAM(8);
    if (IN(9)) { pg8::Gemm g{F.ACT, F.WDN, MT, D, FF}; pg8::StaticOrder S; S.init(MT, D, F.G, (int)blockIdx.x); pg8::EpiF32 E{F.FFN, D, nullptr};
        pg8::gemm_phase<pg8::EpiF32, pg8::StaticOrder, PG8_ALIGN, PG8_SP2>(F.lds, g, S, E); } SEAM(9);
    if (IN(10)) { p10_final(F); }
#undef IN
#undef SEAM
}

#ifndef MK_ONE_LAUNCH
#define MK_ONE_LAUNCH 1
#endif
extern "C" void kernel_launch(void* const* d_in, const int* in_sizes, int n_in, void* d_out, int out_size, void* d_ws, size_t ws_size, hipStream_t stream) {
    static int grid = 0;
    if (grid == 0) {
        if (n_in != 23 || out_size != (int)O_END || ws_size < WS_END) { fprintf(stderr, "kernel_launch: unexpected shapes n_in %d out %d ws %zu\n", n_in, out_size, ws_size); grid = -1; return; }
        int dev = 0, cus = 0;
        if (hipGetDevice(&dev) != hipSuccess || hipDeviceGetAttribute(&cus, hipDeviceAttributeMultiprocessorCount, dev) != hipSuccess) { grid = -1; return; }
        if (hipFuncSetAttribute((const void*)fwd, hipFuncAttributeMaxDynamicSharedMemorySize, LDS_BYTES) != hipSuccess) { fprintf(stderr, "kernel_launch: hipFuncSetAttribute failed\n"); grid = -1; return; }
        int per_cu = 0;
        if (hipOccupancyMaxActiveBlocksPerMultiprocessor(&per_cu, (const void*)fwd, NTHREADS, LDS_BYTES) != hipSuccess || per_cu < 1) fprintf(stderr, "kernel_launch: occupancy query says %d\n", per_cu);
        (void)hipGetLastError();
        grid = cus;
    }
    if (grid < 0) return;
    (void)hipMemsetAsync((char*)d_ws + WS_CTL, 0, CTL_ZERO_BYTES, stream);
    Args a{};
    for (int i = 0; i < 23; ++i) a.in[i] = d_in[i];
    a.out = (float*)d_out; a.ws = (unsigned char*)d_ws;
#if MK_ONE_LAUNCH
    a.ph_lo = 0; a.ph_hi = N_PHASES;
    hipLaunchKernelGGL(fwd, dim3(grid), dim3(NTHREADS), LDS_BYTES, stream, a);
#else
    for (int p = 0; p < N_PHASES; ++p) { a.ph_lo = p; a.ph_hi = p + 1; hipLaunchKernelGGL(fwd, dim3(grid), dim3(NTHREADS), LDS_BYTES, stream, a); }
#endif
}
```

```cpp
#include <hip/hip_runtime.h>
#include <cstdio>
#include <cstdint>
namespace pg8 {
#define PG8_LAS __attribute__((address_space(3)))
typedef unsigned short bf16_t;
typedef short bf16x8 __attribute__((ext_vector_type(8)));
typedef float f32x4 __attribute__((ext_vector_type(4)));
typedef unsigned u32x4 __attribute__((ext_vector_type(4)));
constexpr int BM = 256, BK = 64, HALF = 128, HTB = HALF * BK * 2  , STAGE_BYTES = 8 * HTB, NXCD = 8, WGM = 8;

__host__ __device__ __forceinline__ int lds_byte(int r, int c) { const int st = (r >> 4) * 2 + (c >> 5), rr = r & 15, cc = c & 31, ob = rr * 64 + cc * 2; return st * 1024 + (ob ^ (((ob >> 9) & 1) << 5)); }
__host__ __device__ __forceinline__ void stage_rc(int b, int& R, int& C) { const int st = b / 1024, sb = b % 1024, swz = sb ^ (((sb >> 9) & 1) << 5); R = (st >> 1) * 16 + swz / 64; C = (st & 1) * 32 + (swz % 64) / 2; }
__host__ __device__ __forceinline__ int perm32(int rho) { const int n = rho >> 4, i = rho & 15; return 8 * (i >> 2) + 4 * n + (i & 3); }

struct Unit { int pm, pn; };
struct Gemm { const bf16_t* A; const bf16_t* Bt; int M, N, K; };

struct StaticOrder {
    int nM, nN, nwg, G, c;
    __host__ __device__ void init(int M, int N, int G_, int c_) { nM = M / BM; nN = N / BM; nwg = nM * nN; G = G_; c = c_; }
    __host__ __device__ bool next(int i, Unit& u) const {
        const long L = (long)i * G + c; if (L >= nwg) return false;
        int wgid = (int)L; { const int q = nwg / NXCD, r = nwg % NXCD, xcd = wgid % NXCD, off = wgid / NXCD; wgid = (xcd < r ? xcd * (q + 1) : r * (q + 1) + (xcd - r) * q) + off; }
        const int nig = WGM * nN, gid = wgid / nig, fm = gid * WGM, gsz = (nM - fm) < WGM ? (nM - fm) : WGM;
        u.pm = fm + ((wgid % nig) % gsz); u.pn = (wgid % nig) / gsz; return true;
    }
    __device__ __forceinline__ void a_ready(const Unit&) const {}
    __device__ __forceinline__ void done(const Unit&) const {}
};

__device__ __forceinline__ unsigned cvt_pk_bf16(float lo, float hi) { unsigned r; asm volatile("v_cvt_pk_bf16_f32 %0, %1, %2" : "=v"(r) : "v"(lo), "v"(hi)); return r; }
typedef float f32x2 __attribute__((ext_vector_type(2)));
__device__ __forceinline__ f32x2 gelu_pk(f32x2 v) {
    const f32x2 av = __builtin_elementwise_abs(v), d = av * 0.2316418882f + 1.0f;
    f32x2 t; t.x = __builtin_amdgcn_rcpf(d.x); t.y = __builtin_amdgcn_rcpf(d.y);
    f32x2 q = t * 0.5307027145f + (-0.7265760135f); q = q * t + 0.7107068705f; q = q * t + (-0.142248368f); q = q * t + 0.127414796f; q = q * t;
    const f32x2 s = (v * v) * (-0.72134752044f);
    f32x2 e; e.x = __builtin_amdgcn_exp2f(s.x); e.y = __builtin_amdgcn_exp2f(s.y);
    const f32x2 m = v * (q * e), r = v - m;
    f32x2 o; o.x = v.x < 0.f ? m.x : r.x; o.y = v.y < 0.f ? m.y : r.y; return o;
}

template <int ACT  > struct EpiBf16 {
    static constexpr bool PERM = true, AFTER_DRAIN = false; static_assert(ACT == 0 || ACT == 1, "EpiBf16: ACT is 0 (none) or 1 (gelu_pk)");
    bf16_t* O; int ldc; const float* bias; int split_cols; size_t split_stride; float scale0;
    __device__ __forceinline__ void operator()(const f32x4 (&acc)[2][2][4][2], const Unit& u, int wr, int wc, int fr, int fq) const {
        const int row0 = u.pm * BM + wr * 64 + fr; int colt = u.pn * BM; bf16_t* base = O;
        float sc = 1.f; if (split_cols) { const int t = colt / split_cols; base += (size_t)t * split_stride; colt -= t * split_cols; if (t == 0) sc = scale0; }
        const int col0 = colt + wc * 32 + 8 * fq, bcol0 = u.pn * BM + wc * 32 + 8 * fq;
        f32x4 bv[2][2];
#pragma unroll
        for (int bj = 0; bj < 2; ++bj)
#pragma unroll
            for (int n = 0; n < 2; ++n) bv[bj][n] = bias ? *(const f32x4*)(bias + bcol0 + bj * HALF + 4 * n) : (f32x4){0.f, 0.f, 0.f, 0.f};
#pragma unroll
        for (int ai = 0; ai < 2; ++ai)
#pragma unroll
            for (int m = 0; m < 4; ++m) { bf16_t* rowp = base + (size_t)(row0 + ai * HALF + m * 16) * ldc + col0;
#pragma unroll
                for (int bj = 0; bj < 2; ++bj) { f32x4 v0 = acc[ai][bj][m][0] + bv[bj][0], v1 = acc[ai][bj][m][1] + bv[bj][1];
                    if (ACT == 1) { f32x2 a = gelu_pk((f32x2){v0[0], v0[1]}), b = gelu_pk((f32x2){v0[2], v0[3]}), c = gelu_pk((f32x2){v1[0], v1[1]}), d = gelu_pk((f32x2){v1[2], v1[3]});
                        v0 = (f32x4){a.x, a.y, b.x, b.y}; v1 = (f32x4){c.x, c.y, d.x, d.y}; }
                    v0 = v0 * sc; v1 = v1 * sc; u32x4 w; w.x = cvt_pk_bf16(v0[0], v0[1]); w.y = cvt_pk_bf16(v0[2], v0[3]); w.z = cvt_pk_bf16(v1[0], v1[1]); w.w = cvt_pk_bf16(v1[2], v1[3]);
                    *(u32x4*)(rowp + bj * HALF) = w; } }
    }
};

struct PanelStats {
    unsigned* xbuf;
    unsigned* cnt;
    unsigned* tmo;
    int ntn; float eps;
    unsigned code;
    __device__ __forceinline__ bool run(const f32x4 (&v)[2][2][4][2], const Unit& u, int wr, int wc, int fr, int fq, PG8_LAS unsigned char* lds, int wid, int lane) const {
        typedef float f32x2v __attribute__((ext_vector_type(2)));
        PG8_LAS f32x2v* P = (PG8_LAS f32x2v*)lds;
        PG8_LAS f32x2v* S = (PG8_LAS f32x2v*)(lds + 8192);
        PG8_LAS unsigned* flag = (PG8_LAS unsigned*)(lds + 8192 + 2048);
#pragma unroll
        for (int ai = 0; ai < 2; ++ai)
#pragma unroll
            for (int m = 0; m < 4; ++m) {
                float s = 0.f;
#pragma unroll
                for (int bj = 0; bj < 2; ++bj)
#pragma unroll
                    for (int n = 0; n < 2; ++n) { const f32x4 x = v[ai][bj][m][n]; s += (x[0] + x[1]) + (x[2] + x[3]); }
                s += __shfl_xor(s, 16); s += __shfl_xor(s, 32);
                const float mw = s * (1.0f / 64.0f); float q = 0.f;
#pragma unroll
                for (int bj = 0; bj < 2; ++bj)
#pragma unroll
                    for (int n = 0; n < 2; ++n) { const f32x4 d = v[ai][bj][m][n] - mw; q += (d[0] * d[0] + d[1] * d[1]) + (d[2] * d[2] + d[3] * d[3]); }
                q += __shfl_xor(q, 16); q += __shfl_xor(q, 32);
                if (fq == 0) P[(ai * HALF + wr * 64 + m * 16 + fr) * 4 + wc] = (f32x2v){mw, q};
            }
        asm volatile("s_waitcnt lgkmcnt(0)" ::: "memory"); __builtin_amdgcn_s_barrier(); asm volatile("" ::: "memory");
#if defined(BROKEN_EXCHANGE_NO_WAIT)
#warning BROKEN CONTROL BUILD: the row-statistics exchange does not wait; results are wrong by design
        if (blockIdx.x >= 64) { const long long t0_ = clock64(); while (clock64() - t0_ < 60000) __builtin_amdgcn_s_sleep(8); }
#endif
        const int row = wid * 32 + (lane & 31);
        if (lane < 32) {
            const f32x2v a = P[row * 4 + 0], b = P[row * 4 + 1], c = P[row * 4 + 2], d = P[row * 4 + 3];
            const float mt = (a.x + b.x + c.x + d.x) * 0.25f;
            const float da = a.x - mt, db = b.x - mt, dc = c.x - mt, dd = d.x - mt;
            const float m2 = (a.y + b.y) + (c.y + d.y) + 64.0f * ((da * da + db * db) + (dc * dc + dd * dd));
            unsigned long long* slot = (unsigned long long*)xbuf + ((size_t)(u.pm * BM + row) * 4 + u.pn);
            __hip_atomic_store(slot, ((unsigned long long)__float_as_uint(m2) << 32) | __float_as_uint(mt), __ATOMIC_RELAXED, __HIP_MEMORY_SCOPE_AGENT);
        }
        asm volatile("s_waitcnt vmcnt(0)" ::: "memory");
        if (lane == 0) __hip_atomic_fetch_add(cnt + 64 * u.pm, 1u, __ATOMIC_RELAXED, __HIP_MEMORY_SCOPE_AGENT);
        if (wid == 0) {
            bool dead = false; const unsigned long long t0 = __builtin_amdgcn_s_memrealtime(); const unsigned want = 8u * (unsigned)ntn;
            for (;;) {
#if defined(BROKEN_EXCHANGE_NO_WAIT)
                break;
#endif
                if ((unsigned)__builtin_amdgcn_readfirstlane(__hip_atomic_load(cnt + 64 * u.pm, __ATOMIC_RELAXED, __HIP_MEMORY_SCOPE_AGENT)) >= want) break;
                if (__builtin_amdgcn_s_memrealtime() - t0 > 2000000ull) {
                    if (lane == 0) { unsigned expect = 0u; __hip_atomic_compare_exchange_strong(tmo + 1, &expect, code | (unsigned)(u.pm & 0xff), __ATOMIC_RELAXED, __ATOMIC_RELAXED, __HIP_MEMORY_SCOPE_AGENT);
                                     __hip_atomic_store(tmo, 1u, __ATOMIC_RELAXED, __HIP_MEMORY_SCOPE_AGENT); }
                    dead = true; break; }
                __builtin_amdgcn_s_sleep(2);
            }
            __builtin_amdgcn_fence(__ATOMIC_ACQUIRE, "agent");
            if (lane == 0) flag[0] = dead ? 1u : 0u;
        }
        asm volatile("s_waitcnt vmcnt(0) lgkmcnt(0)" ::: "memory"); __builtin_amdgcn_s_barrier(); asm volatile("" ::: "memory");
        const bool bad = flag[0] != 0u;
        if (lane < 32) {
            const unsigned long long* slot = (const unsigned long long*)xbuf + (size_t)(u.pm * BM + row) * 4; float mt[4], m2[4]; float ms = 0.f;
#pragma unroll
            for (int t = 0; t < 4; ++t) { if (t < ntn) { const unsigned long long w = __hip_atomic_load(slot + t, __ATOMIC_RELAXED, __HIP_MEMORY_SCOPE_AGENT); mt[t] = __uint_as_float((unsigned)w); m2[t] = __uint_as_float((unsigned)(w >> 32)); } else { mt[t] = 0.f; m2[t] = 0.f; } ms += mt[t]; }
            const float mean = ms / (float)ntn; float q = 0.f;
#pragma unroll
            for (int t = 0; t < 4; ++t) if (t < ntn) { const float dm = mt[t] - mean; q += m2[t] + 256.0f * dm * dm; }
            S[row] = (f32x2v){mean, 1.0f / sqrtf(q / (256.0f * (float)ntn) + eps)};
        }
        asm volatile("s_waitcnt lgkmcnt(0)" ::: "memory"); __builtin_amdgcn_s_barrier(); asm volatile("" ::: "memory");
        return bad;
    }
};
struct EpiLnRes {
    static constexpr bool PERM = false, AFTER_DRAIN = true;
    const float* base; float* out; int ldc; const float* bias; PanelStats st; unsigned poison;
    __device__ __forceinline__ void fused(f32x4 (&acc)[2][2][4][2], const Unit& u, int wr, int wc, int fr, int fq, PG8_LAS unsigned char* lds, int wid, int lane) const {
        typedef float f32x2v __attribute__((ext_vector_type(2)));
        const PG8_LAS f32x2v* S = (const PG8_LAS f32x2v*)(lds + 8192);
        const int col0 = u.pn * BM + wc * 32 + 4 * fq;
#pragma unroll
        for (int bj = 0; bj < 2; ++bj)
#pragma unroll
            for (int n = 0; n < 2; ++n) { const f32x4 bv = bias ? *(const f32x4*)(bias + col0 + bj * HALF + n * 16) : (f32x4){0.f, 0.f, 0.f, 0.f};
#pragma unroll
                for (int ai = 0; ai < 2; ++ai)
#pragma unroll
                    for (int m = 0; m < 4; ++m) acc[ai][bj][m][n] += bv; }
        f32x4 pre[4][2][2];
#pragma unroll
        for (int m = 0; m < 4; ++m) { const size_t off = (size_t)(u.pm * BM + wr * 64 + m * 16 + fr) * ldc + col0;
#pragma unroll
            for (int bj = 0; bj < 2; ++bj)
#pragma unroll
                for (int n = 0; n < 2; ++n) pre[m][bj][n] = *(const f32x4*)(base + off + bj * HALF + n * 16); }
        const bool bad = st.run(acc, u, wr, wc, fr, fq, lds, wid, lane) || poison != 0u;
        const float qnan = __builtin_nanf("");
#pragma unroll
        for (int ai = 0; ai < 2; ++ai)
#pragma unroll
            for (int m = 0; m < 4; ++m) { const int r = ai * HALF + wr * 64 + m * 16 + fr; const f32x2v sr = S[r]; const size_t off = (size_t)(u.pm * BM + r) * ldc + col0;
#pragma unroll
                for (int bj = 0; bj < 2; ++bj)
#pragma unroll
                    for (int n = 0; n < 2; ++n) { const f32x4 bs = ai == 0 ? pre[m][bj][n] : *(const f32x4*)(base + off + bj * HALF + n * 16); f32x4 o = bs + (acc[ai][bj][m][n] - sr.x) * sr.y;
                        if (bad) o = (f32x4){qnan, qnan, qnan, qnan}; *(f32x4*)(out + off + bj * HALF + n * 16) = o; }
                if (m & 1) asm volatile("" ::: "memory"); }
    }
};
struct EpiLnResLn {
    static constexpr bool PERM = false, AFTER_DRAIN = true;
    const float* base; float* out; bf16_t* xn; int ldc; const float* bias; PanelStats st1, st2; unsigned poison;
    __device__ __forceinline__ void fused(f32x4 (&acc)[2][2][4][2], const Unit& u, int wr, int wc, int fr, int fq, PG8_LAS unsigned char* lds, int wid, int lane) const {
        typedef float f32x2v __attribute__((ext_vector_type(2))); typedef unsigned u32x2v __attribute__((ext_vector_type(2)));
        const PG8_LAS f32x2v* S = (const PG8_LAS f32x2v*)(lds + 8192);
        const int col0 = u.pn * BM + wc * 32 + 4 * fq;
#pragma unroll
        for (int bj = 0; bj < 2; ++bj)
#pragma unroll
            for (int n = 0; n < 2; ++n) { const f32x4 bv = bias ? *(const f32x4*)(bias + col0 + bj * HALF + n * 16) : (f32x4){0.f, 0.f, 0.f, 0.f};
#pragma unroll
                for (int ai = 0; ai < 2; ++ai)
#pragma unroll
                    for (int m = 0; m < 4; ++m) acc[ai][bj][m][n] += bv; }
        bool bad = st1.run(acc, u, wr, wc, fr, fq, lds, wid, lane) || poison != 0u;
        const float qnan = __builtin_nanf("");
#pragma unroll
        for (int ai = 0; ai < 2; ++ai)
#pragma unroll
            for (int m = 0; m < 4; ++m) { const int r = ai * HALF + wr * 64 + m * 16 + fr; const f32x2v sr = S[r]; const size_t off = (size_t)(u.pm * BM + r) * ldc + col0;
#pragma unroll
                for (int bj = 0; bj < 2; ++bj)
#pragma unroll
                    for (int n = 0; n < 2; ++n) { const f32x4 bs = *(const f32x4*)(base + off + bj * HALF + n * 16); acc[ai][bj][m][n] = bs + (acc[ai][bj][m][n] - sr.x) * sr.y; }
                asm volatile("" : "+v"(acc[ai][0][m][0]), "+v"(acc[ai][0][m][1]), "+v"(acc[ai][1][m][0]), "+v"(acc[ai][1][m][1]));
                if (m & 1) asm volatile("" ::: "memory"); }
        const bool bad1 = bad;
        bad = st2.run(acc, u, wr, wc, fr, fq, lds, wid, lane) || bad;
#pragma unroll
        for (int ai = 0; ai < 2; ++ai)
#pragma unroll
            for (int m = 0; m < 4; ++m) { const int r = ai * HALF + wr * 64 + m * 16 + fr; const f32x2v sr = S[r]; const size_t off = (size_t)(u.pm * BM + r) * ldc + col0;
#pragma unroll
                for (int bj = 0; bj < 2; ++bj)
#pragma unroll
                    for (int n = 0; n < 2; ++n) { const f32x4 x1 = acc[ai][bj][m][n]; *(f32x4*)(out + off + bj * HALF + n * 16) = bad1 ? (f32x4){qnan, qnan, qnan, qnan} : x1;
                        const f32x4 o = (x1 - sr.x) * sr.y; u32x2v w; w.x = cvt_pk_bf16(o[0], o[1]); w.y = cvt_pk_bf16(o[2], o[3]);
                        if (bad) { w.x = 0x7fc07fc0u; w.y = 0x7fc07fc0u; } *(u32x2v*)(xn + off + bj * HALF + n * 16) = w; }
                asm volatile("" ::: "memory"); }
    }
};

template <class Epi, class Sched, bool ALIGN_EPI = false, bool SP2 = false>
__device__ __forceinline__ void gemm_phase(PG8_LAS unsigned char* lds, const Gemm g, const Sched& S, const Epi& E) {
    const int tid = threadIdx.x, wid = __builtin_amdgcn_readfirstlane(tid >> 6), lane = tid & 63, wr = wid >> 2, wc = wid & 3, fr = lane & 15, fq = lane >> 4;
    const int K = g.K, nt = K / BK;
    unsigned voffA[2], voffB[2];
#pragma unroll
    for (int i = 0; i < 2; ++i) { int R, C; stage_rc(tid * 16 + i * 8192, R, C); const int Rb = Epi::PERM ? ((R & ~31) + perm32(R & 31)) : R;
        voffA[i] = (unsigned)(R * K + C) * 2u; voffB[i] = (unsigned)(Rb * K + C) * 2u; }
    const size_t kstep = (size_t)(BK * 2);
    const size_t hstep = (size_t)HALF * K * 2;
    const size_t tstep = 2 * hstep;
    const unsigned ldsw = (unsigned)wid * 1024u;
    const int aoff = lds_byte(wr * 64 + fr, fq * 8), boff = lds_byte(wc * 32 + fr, fq * 8);
#define PG8_SA(b, h) (((b) * 2 + (h)) * HTB)
#define PG8_SB(b, h) ((4 + (b) * 2 + (h)) * HTB)
#define PG8_STAGE(bufoff, gbase, voff) do { _Pragma("unroll") for (int _i = 0; _i < 2; ++_i) \
        __builtin_amdgcn_global_load_lds((const unsigned*)((const char*)(gbase) + (voff)[_i]), (PG8_LAS unsigned*)(lds + (bufoff) + ldsw + _i * 8192), 16, 0, 0); } while (0)
#define PG8_LDA(dst, b, h) do { _Pragma("unroll") for (int m = 0; m < 4; ++m) _Pragma("unroll") for (int k = 0; k < 2; ++k) dst[m][k] = *(const PG8_LAS bf16x8*)(lds + PG8_SA(b, h) + aoff + m * 2048 + k * 1024); } while (0)
#define PG8_LDB(dst, b, h) do { _Pragma("unroll") for (int n = 0; n < 2; ++n) _Pragma("unroll") for (int k = 0; k < 2; ++k) dst[n][k] = *(const PG8_LAS bf16x8*)(lds + PG8_SB(b, h) + boff + n * 2048 + k * 1024); } while (0)
#define PG8_MMA(ai, bj, At, Bt) do { __builtin_amdgcn_s_setprio(1); _Pragma("unroll") for (int m = 0; m < 4; ++m) _Pragma("unroll") for (int n = 0; n < 2; ++n) _Pragma("unroll") for (int k = 0; k < 2; ++k) \
        acc[ai][bj][m][n] = __builtin_amdgcn_mfma_f32_16x16x32_bf16(Bt[n][k], At[m][k], acc[ai][bj][m][n], 0, 0, 0); __builtin_amdgcn_s_setprio(0); } while (0)
#define PG8_WAIT_V(n) asm volatile("s_waitcnt vmcnt(" #n ")" ::: "memory")
#define PG8_WAIT_L(n) asm volatile("s_waitcnt lgkmcnt(" #n ")" ::: "memory")
#define PG8_BAR __builtin_amdgcn_s_barrier()
#define PG8_SCHED __builtin_amdgcn_sched_barrier(0)
    Unit cur, nxt; int ui = 0;
    if (!S.next(0, cur)) return;
    f32x4 acc[2][2][4][2];
#pragma unroll
    for (int a = 0; a < 2; ++a)
#pragma unroll
        for (int b = 0; b < 2; ++b)
#pragma unroll
            for (int m = 0; m < 4; ++m)
#pragma unroll
                for (int n = 0; n < 2; ++n) acc[a][b][m][n] = (f32x4){0.f, 0.f, 0.f, 0.f};
    bf16x8 At[4][2], B0[2][2], B1[2][2];
    const char* cA = (const char*)g.A + (size_t)cur.pm * tstep; const char* cB = (const char*)g.Bt + (size_t)cur.pn * tstep;
    S.a_ready(cur);
    if constexpr (SP2) {
        PG8_STAGE(PG8_SB(0, 0), cB, voffB); PG8_STAGE(PG8_SB(0, 1), cB + hstep, voffB); PG8_STAGE(PG8_SA(0, 0), cA, voffA); PG8_STAGE(PG8_SA(0, 1), cA + hstep, voffA);
        if (wr == 1) PG8_BAR;
        PG8_WAIT_V(2); PG8_BAR;
        PG8_STAGE(PG8_SB(1, 0), cB + kstep, voffB); PG8_STAGE(PG8_SA(1, 0), cA + kstep, voffA); PG8_STAGE(PG8_SB(1, 1), cB + hstep + kstep, voffB);
        PG8_WAIT_V(6); PG8_BAR;
    } else {
        PG8_STAGE(PG8_SB(0, 0), cB, voffB); PG8_STAGE(PG8_SA(0, 0), cA, voffA); PG8_STAGE(PG8_SB(0, 1), cB + hstep, voffB); PG8_STAGE(PG8_SA(0, 1), cA + hstep, voffA);
        if (wr == 1) PG8_BAR;
        PG8_WAIT_V(4); PG8_BAR;
        PG8_STAGE(PG8_SB(1, 0), cB + kstep, voffB); PG8_STAGE(PG8_SA(1, 0), cA + kstep, voffA); PG8_STAGE(PG8_SB(1, 1), cB + hstep + kstep, voffB);
        PG8_WAIT_V(6); PG8_BAR;
    }
    for (;;) {
        const bool has_next = S.next(ui + 1, nxt);
        const char* nA = has_next ? (const char*)g.A + (size_t)nxt.pm * tstep : cA; const char* nB = has_next ? (const char*)g.Bt + (size_t)nxt.pn * tstep : cB;
        for (int t = 0; t < nt; t += 2) {
            const bool last = (t == nt - 2);
            const char* a1 = cA + (size_t)(t + 1) * kstep;
            const char* a2 = last ? nA : cA + (size_t)(t + 2) * kstep; const char* b2 = last ? nB : cB + (size_t)(t + 2) * kstep;
            const char* a3 = a2 + kstep; const char* b3 = b2 + kstep;
            if (last && has_next) S.a_ready(nxt);
            if constexpr (SP2) {
            PG8_LDB(B0, 0, 0); PG8_LDB(B1, 0, 1); PG8_SCHED; PG8_LDA(At, 0, 0); PG8_STAGE(PG8_SA(1, 1), a1 + hstep, voffA);
            PG8_WAIT_V(8); PG8_WAIT_L(0); PG8_BAR; PG8_MMA(0, 0, At, B0); PG8_MMA(0, 1, At, B1); PG8_BAR; PG8_SCHED;
            PG8_LDA(At, 0, 1); PG8_STAGE(PG8_SB(0, 0), b2, voffB); PG8_STAGE(PG8_SB(0, 1), b2 + hstep, voffB); PG8_STAGE(PG8_SA(0, 0), a2, voffA);
            PG8_WAIT_V(8); PG8_WAIT_L(0); PG8_BAR; PG8_MMA(1, 0, At, B0); PG8_MMA(1, 1, At, B1); PG8_BAR; PG8_SCHED;
            PG8_LDB(B0, 1, 0); PG8_LDB(B1, 1, 1); PG8_SCHED; PG8_LDA(At, 1, 0); PG8_STAGE(PG8_SA(0, 1), a2 + hstep, voffA);
            PG8_WAIT_V(8); PG8_WAIT_L(0); PG8_BAR; PG8_MMA(0, 0, At, B0); PG8_MMA(0, 1, At, B1); PG8_BAR; PG8_SCHED;
            PG8_LDA(At, 1, 1); PG8_STAGE(PG8_SB(1, 0), b3, voffB); PG8_STAGE(PG8_SB(1, 1), b3 + hstep, voffB); PG8_STAGE(PG8_SA(1, 0), a3, voffA);
            PG8_WAIT_V(8); PG8_WAIT_L(0); PG8_BAR; PG8_MMA(1, 0, At, B0); PG8_MMA(1, 1, At, B1); PG8_BAR; PG8_SCHED;
            } else {
            PG8_LDB(B0, 0, 0); PG8_SCHED; PG8_LDA(At, 0, 0); PG8_STAGE(PG8_SA(1, 1), a1 + hstep, voffA);
            PG8_WAIT_L(8); PG8_BAR; PG8_WAIT_L(0); PG8_MMA(0, 0, At, B0); PG8_BAR; PG8_SCHED;
            PG8_LDB(B1, 0, 1); PG8_STAGE(PG8_SB(0, 0), b2, voffB);
            PG8_BAR; PG8_WAIT_L(0); PG8_MMA(0, 1, At, B1); PG8_BAR;
            PG8_LDA(At, 0, 1); PG8_STAGE(PG8_SA(0, 0), a2, voffA);
            PG8_BAR; PG8_WAIT_L(0); PG8_MMA(1, 0, At, B0); PG8_BAR; PG8_SCHED;
            PG8_STAGE(PG8_SB(0, 1), b2 + hstep, voffB);
            PG8_WAIT_V(6); PG8_BAR; PG8_MMA(1, 1, At, B1); PG8_BAR;
            PG8_LDB(B0, 1, 0); PG8_SCHED; PG8_LDA(At, 1, 0); PG8_STAGE(PG8_SA(0, 1), a2 + hstep, voffA);
            PG8_WAIT_L(8); PG8_BAR; PG8_WAIT_L(0); PG8_MMA(0, 0, At, B0); PG8_BAR; PG8_SCHED;
            PG8_LDB(B1, 1, 1); PG8_STAGE(PG8_SB(1, 0), b3, voffB);
            PG8_BAR; PG8_WAIT_L(0); PG8_MMA(0, 1, At, B1); PG8_BAR;
            PG8_LDA(At, 1, 1); PG8_STAGE(PG8_SA(1, 0), a3, voffA);
            PG8_BAR; PG8_WAIT_L(0); PG8_MMA(1, 0, At, B0); PG8_BAR; PG8_SCHED;
            PG8_STAGE(PG8_SB(1, 1), b3 + hstep, voffB);
            PG8_WAIT_V(6); PG8_BAR; PG8_MMA(1, 1, At, B1); PG8_BAR;
            }
        }
        if constexpr (ALIGN_EPI) { if (wr == 0) PG8_BAR; }
        if constexpr (!Epi::AFTER_DRAIN) { E(acc, cur, wr, wc, fr, fq); S.done(cur); }
        if (!has_next) break;
#pragma unroll
        for (int a = 0; a < 2; ++a)
#pragma unroll
            for (int b = 0; b < 2; ++b)
#pragma unroll
                for (int m = 0; m < 4; ++m)
#pragma unroll
                    for (int n = 0; n < 2; ++n) acc[a][b][m][n] = (f32x4){0.f, 0.f, 0.f, 0.f};
        cur = nxt; cA = nA; cB = nB; ++ui;
        if constexpr (ALIGN_EPI) { if (wr == 1) PG8_BAR; }
    }
    PG8_WAIT_V(0);
    if constexpr (!ALIGN_EPI) { if (wr == 0) PG8_BAR; }
    PG8_BAR;
    if constexpr (Epi::AFTER_DRAIN) { E.fused(acc, cur, wr, wc, fr, fq, lds, wid, lane); S.done(cur); }
#undef PG8_SA
#undef PG8_SB
#undef PG8_STAGE
#undef PG8_LDA
#undef PG8_LDB
#undef PG8_MMA
#undef PG8_WAIT_V
#undef PG8_WAIT_L
#undef PG8_BAR
#undef PG8_SCHED
}
}
namespace pg8 {
struct EpiF32 {
    static constexpr bool PERM = false, AFTER_DRAIN = false;
    float* C; int ldc; const float* bias;
    __device__ __forceinline__ void operator()(const f32x4 (&acc)[2][2][4][2], const Unit& u, int wr, int wc, int fr, int fq) const {
        const int row0 = u.pm * BM + wr * 64 + fr, col0 = u.pn * BM + wc * 32 + 4 * fq;
        f32x4 bv[2][2];
#pragma unroll
        for (int bj = 0; bj < 2; ++bj)
#pragma unroll
            for (int n = 0; n < 2; ++n) bv[bj][n] = bias ? *(const f32x4*)(bias + col0 + bj * HALF + n * 16) : (f32x4){0.f, 0.f, 0.f, 0.f};
#pragma unroll
        for (int ai = 0; ai < 2; ++ai)
#pragma unroll
            for (int m = 0; m < 4; ++m) { float* rowp = C + (size_t)(row0 + ai * HALF + m * 16) * ldc + col0;
#pragma unroll
                for (int bj = 0; bj < 2; ++bj)
#pragma unroll
                    for (int n = 0; n < 2; ++n) *(f32x4*)(rowp + bj * HALF + n * 16) = acc[ai][bj][m][n] + bv[bj][n]; }
    }
};
}
#ifndef PG8_SP2
#define PG8_SP2 true
#endif
#ifndef PG8_ALIGN
#define PG8_ALIGN true
#endif
#define GAS __attribute__((address_space(1)))
#define LAS __attribute__((address_space(3)))
typedef unsigned short bf16;
typedef unsigned v4u __attribute__((ext_vector_type(4)));
typedef float f32x4 __attribute__((ext_vector_type(4)));
typedef short bf16x8 __attribute__((ext_vector_type(8)));
typedef GAS unsigned gu32;
typedef GAS unsigned long long gu64;
#define RLX_AGENT __ATOMIC_RELAXED, __HIP_MEMORY_SCOPE_AGENT
#define LDS_WAIT() asm volatile("s_waitcnt lgkmcnt(0)" ::: "memory")
#define VM_WAIT() asm volatile("s_waitcnt vmcnt(0)" ::: "memory")
__device__ __forceinline__ unsigned long long rt() { return __builtin_amdgcn_s_memrealtime(); }
__device__ __forceinline__ unsigned f2bf(float f) { unsigned u = __builtin_bit_cast(unsigned, f); return (u + 0x7fffu + ((u >> 16) & 1u)) >> 16; }
__device__ __forceinline__ unsigned pk2(float lo, float hi) { return f2bf(lo) | (f2bf(hi) << 16); }

#define XB_TMO      128
#define XB_XCNT(j)  (256  + 64 * (j))
#define XB_XSUB(j)  (1280 + 64 * (j))
#define XB_XGEN(j)  (2304 + 64 * (j))
#define XB_TOP      3328
#define XB_TOPGEN   3392
#define XCD_BAR_WORDS 3456
#define XB_SPIN_CAP (1u << 18)

__device__ __forceinline__ unsigned xb_ld(unsigned* p)              { return __hip_atomic_load(p, __ATOMIC_RELAXED, __HIP_MEMORY_SCOPE_AGENT); }
__device__ __forceinline__ unsigned xb_add(unsigned* p, unsigned v) { return __hip_atomic_fetch_add(p, v, __ATOMIC_RELAXED, __HIP_MEMORY_SCOPE_AGENT); }
__device__ __forceinline__ unsigned xb_xcc_id() { return (unsigned)__builtin_amdgcn_s_getreg((3 << 11) | 20) & 0xFu; }
#define XB_SPIN(cond, bar) do { unsigned _sp = 0; while (cond) { __builtin_amdgcn_s_sleep(1); \
    if ((++_sp & 255u) == 0u) { if (xb_ld(&(bar)[XB_TMO])) break; if (_sp > XB_SPIN_CAP) { atomicAdd(&(bar)[XB_TMO], 1u); break; } } } } while (0)

struct XcdBarrier {
    unsigned* bar; unsigned x;
    volatile LAS unsigned* st;
};

__device__ __forceinline__ XcdBarrier xcd_barrier_post(unsigned* bar, volatile LAS unsigned* st) {
    XcdBarrier b; b.bar = bar; b.x = xb_xcc_id(); b.st = st;
    if (threadIdx.x == 0) (void)xb_add(&bar[XB_XCNT(b.x)], 1u);
    return b;
}
__device__ __forceinline__ void xcd_barrier_complete(unsigned* bar, unsigned x, unsigned& nloc, unsigned& nx) {
    const unsigned G = gridDim.x * gridDim.y * gridDim.z;
    unsigned sum, cnt, mine, sp = 0u;
    for (;;) {
        sum = 0u; cnt = 0u; mine = 0u;
#pragma unroll
        for (unsigned j = 0; j < 16; ++j) { const unsigned c = xb_ld(&bar[XB_XCNT(j)]); sum += c; cnt += (c > 0u) ? 1u : 0u; mine = (j == x) ? c : mine; }
        if (sum == G) break;
        __builtin_amdgcn_s_sleep(1);
        if ((++sp & 255u) == 0u) { if (xb_ld(&bar[XB_TMO])) break; if (sp > XB_SPIN_CAP) { atomicAdd(&bar[XB_TMO], 1u); break; } }
    }
    nloc = mine > 0u ? mine : 1u; nx = cnt > 0u ? cnt : 1u;
}

__device__ __forceinline__ void xcd_barrier(const XcdBarrier& b) {
    asm volatile("s_waitcnt vmcnt(0)" ::: "memory");
    __syncthreads();
    if (threadIdx.x == 0) {
        unsigned* bar = b.bar;
        __builtin_amdgcn_s_waitcnt(0);
        unsigned nloc = b.st[0], nx = b.st[1];
        if (nloc == 0u) { xcd_barrier_complete(bar, b.x, nloc, nx); b.st[0] = nloc; b.st[1] = nx; }
        const unsigned old = xb_add(&bar[XB_XSUB(b.x)], 1u);
        const unsigned gen = old / nloc;
        if (old + 1u == (gen + 1u) * nloc) {
            __builtin_amdgcn_fence(__ATOMIC_RELEASE, "agent");
            asm volatile("s_waitcnt vmcnt(0)" ::: "memory");
            const unsigned og = xb_add(&bar[XB_TOP], 1u);
            const unsigned tg = og / nx;
            if (og + 1u == (tg + 1u) * nx) xb_add(&bar[XB_TOPGEN], 1u);
            else XB_SPIN(xb_ld(&bar[XB_TOPGEN]) == tg, bar);
            __builtin_amdgcn_fence(__ATOMIC_ACQUIRE, "agent");
            xb_add(&bar[XB_XGEN(b.x)], 1u);
            asm volatile("s_waitcnt vmcnt(0)" ::: "memory");
        } else {
            XB_SPIN(xb_ld(&bar[XB_XGEN(b.x)]) == gen, bar);
            __builtin_amdgcn_fence(__ATOMIC_ACQUIRE, "agent");
            asm volatile("s_waitcnt vmcnt(0)" ::: "memory");
        }
    }
    __syncthreads();
}

namespace mb {
typedef short bf16x8 __attribute__((ext_vector_type(8)));
typedef short s16x4 __attribute__((ext_vector_type(4)));
typedef float f32x16 __attribute__((ext_vector_type(16)));
typedef unsigned u32x4 __attribute__((ext_vector_type(4)));
typedef __attribute__((address_space(3))) const char* lds_cptr;
constexpr float C2 = 0.125f * 1.4426950408889634f;
constexpr int PITCH = 512;
constexpr int L_K = 0, L_V = 32768, L_STG = 65536, STG_W = 8704  , L_MISC = 135168;
constexpr int M_WSF = 0, M_PRE = 2048, M_ROW = 4608, M_SCAL = 4864;
__device__ __forceinline__ int crow(int r, int hi) { return (r & 3) + 8 * (r >> 2) + 4 * hi; }
__device__ __forceinline__ void glds16(const void* gsrc, unsigned lds_dst) { unsigned keep;
    asm volatile("s_mov_b32 %0, m0\n\ts_mov_b32 m0, %2\n\ts_nop 0\n\tglobal_load_lds_dwordx4 %1, off\n\ts_mov_b32 m0, %0" : "=&s"(keep) : "v"(gsrc), "s"(lds_dst) : "memory"); }
typedef float f32x2_t __attribute__((ext_vector_type(2))); typedef __bf16 bf16x2_t __attribute__((ext_vector_type(2)));
__device__ __forceinline__ unsigned cvtpk_s(float lo, float hi) { f32x2_t v = {lo, hi}; bf16x2_t b = __builtin_convertvector(v, bf16x2_t); return __builtin_bit_cast(unsigned, b); }

__device__ __forceinline__ void stage_kv(const bf16* KB, const bf16* VB, size_t krow0, int hcol, unsigned lds0, int wid, int lane) {
    const bf16* ksrc = KB + (krow0 + lane) * PITCH + hcol + wid * 8;
    const bf16* vsrc = VB + (krow0 + 16 * (wid & 3) + (lane >> 2)) * PITCH + hcol + (wid >> 2) * 32 + (lane & 3) * 8;
#pragma unroll
    for (int j = 0; j < 4; ++j) {
        glds16(ksrc + (size_t)j * 64 * PITCH, (unsigned)__builtin_amdgcn_readfirstlane(lds0 + L_K + j * 8192 + wid * 1024));
        glds16(vsrc + (size_t)j * 64 * PITCH, (unsigned)__builtin_amdgcn_readfirstlane(lds0 + L_V + j * 8192 + wid * 1024));
    }
}
__device__ __forceinline__ void qkt(f32x16& p0, f32x16& p1, lds_cptr Kslot, const bf16x8 (&qr)[4], int r32, int hi) {
    const lds_cptr kb = Kslot + hi * 1024 + r32 * 16;
    const f32x16 z = {};
#pragma unroll
    for (int d0 = 0; d0 < 4; ++d0) {
        const bf16x8 b0 = *(const __attribute__((address_space(3))) bf16x8*)(kb + d0 * 2048);
        const bf16x8 b1 = *(const __attribute__((address_space(3))) bf16x8*)(kb + d0 * 2048 + 512);
        if (d0 == 0) { p0 = __builtin_amdgcn_mfma_f32_32x32x16_bf16(b0, qr[0], z, 0, 0, 0); p1 = __builtin_amdgcn_mfma_f32_32x32x16_bf16(b1, qr[0], z, 0, 0, 0); }
        else { p0 = __builtin_amdgcn_mfma_f32_32x32x16_bf16(b0, qr[d0], p0, 0, 0, 0); p1 = __builtin_amdgcn_mfma_f32_32x32x16_bf16(b1, qr[d0], p1, 0, 0, 0); }
    }
}
__device__ __forceinline__ void pv(f32x16 (&o)[2], int vb, bf16x8 pa0, bf16x8 pa1, bf16x8 pa2, bf16x8 pa3) {
#pragma unroll
    for (int d0 = 0; d0 < 2; ++d0) { s16x4 lo[4], hi[4];
#pragma unroll
        for (int ks = 0; ks < 4; ++ks) {
            asm volatile("ds_read_b64_tr_b16 %0,%1 offset:%c2" : "=&v"(lo[ks]) : "v"(vb), "i"(d0 * 4096 + ks * 1024) : "memory");
            asm volatile("ds_read_b64_tr_b16 %0,%1 offset:%c2" : "=&v"(hi[ks]) : "v"(vb), "i"(d0 * 4096 + ks * 1024 + 512) : "memory"); }
        asm volatile("s_waitcnt lgkmcnt(0)" ::: "memory"); __builtin_amdgcn_sched_barrier(0);
#define MB_PK(k) (bf16x8){lo[k][0], lo[k][1], lo[k][2], lo[k][3], hi[k][0], hi[k][1], hi[k][2], hi[k][3]}
        o[d0] = __builtin_amdgcn_mfma_f32_32x32x16_bf16(pa0, MB_PK(0), o[d0], 0, 0, 0);
        o[d0] = __builtin_amdgcn_mfma_f32_32x32x16_bf16(pa1, MB_PK(1), o[d0], 0, 0, 0);
        o[d0] = __builtin_amdgcn_mfma_f32_32x32x16_bf16(pa2, MB_PK(2), o[d0], 0, 0, 0);
        o[d0] = __builtin_amdgcn_mfma_f32_32x32x16_bf16(pa3, MB_PK(3), o[d0], 0, 0, 0);
#undef MB_PK
    }
}
template <bool CAUSAL> __device__ __forceinline__ void attend256(const bf16x8 (&qr)[4], lds_cptr lds, unsigned lds0, int lane, int qloc, int jmax, float& m_out, float& l_out, f32x16 (&o)[2]) {
    const int r32 = lane & 31, hi = lane >> 5;
    f32x16 p0[4], p1[4];
#pragma unroll
    for (int j = 0; j < 4; ++j) {
        if (!CAUSAL || j <= jmax) {
            qkt(p0[j], p1[j], lds + L_K + j * 8192, qr, r32, hi);
            if (CAUSAL) {
#pragma unroll
                for (int r = 0; r < 16; ++r) { const int kv = 64 * j + crow(r, hi); if (kv > qloc) p0[j][r] = -INFINITY; if (kv + 32 > qloc) p1[j][r] = -INFINITY; }
            }
        } else {
#pragma unroll
            for (int r = 0; r < 16; ++r) { p0[j][r] = -INFINITY; p1[j][r] = -INFINITY; }
        }
    }
    float mx = -INFINITY;
#pragma unroll
    for (int j = 0; j < 4; ++j)
#pragma unroll
        for (int r = 0; r < 16; ++r) mx = fmaxf(mx, fmaxf(p0[j][r], p1[j][r]));
    mx = fmaxf(mx, __shfl_xor(mx, 32));
    float ls = 0.f;
    o[0] = f32x16{}; o[1] = f32x16{};
    const int vb0 = (int)(lds0 + L_V) + ((lane >> 4) & 1) * 32 + (lane & 3) * 8 + (4 * hi + ((lane & 15) >> 2)) * 64;
#pragma unroll
    for (int j = 0; j < 4; ++j) {
        if (!CAUSAL || j <= jmax) {
#pragma unroll
            for (int r = 0; r < 16; ++r) { p0[j][r] = __builtin_amdgcn_exp2f(p0[j][r] - mx); p1[j][r] = __builtin_amdgcn_exp2f(p1[j][r] - mx); ls += p0[j][r] + p1[j][r]; }
            u32x4 pw0, pw1, pw2, pw3;
            pw0 = (u32x4){cvtpk_s(p0[j][0], p0[j][1]), cvtpk_s(p0[j][2], p0[j][3]), cvtpk_s(p0[j][4], p0[j][5]), cvtpk_s(p0[j][6], p0[j][7])};
            pw1 = (u32x4){cvtpk_s(p0[j][8], p0[j][9]), cvtpk_s(p0[j][10], p0[j][11]), cvtpk_s(p0[j][12], p0[j][13]), cvtpk_s(p0[j][14], p0[j][15])};
            pw2 = (u32x4){cvtpk_s(p1[j][0], p1[j][1]), cvtpk_s(p1[j][2], p1[j][3]), cvtpk_s(p1[j][4], p1[j][5]), cvtpk_s(p1[j][6], p1[j][7])};
            pw3 = (u32x4){cvtpk_s(p1[j][8], p1[j][9]), cvtpk_s(p1[j][10], p1[j][11]), cvtpk_s(p1[j][12], p1[j][13]), cvtpk_s(p1[j][14], p1[j][15])};
            pv(o, vb0 + j * 8192, __builtin_bit_cast(bf16x8, pw0), __builtin_bit_cast(bf16x8, pw1), __builtin_bit_cast(bf16x8, pw2), __builtin_bit_cast(bf16x8, pw3));
        }
    }
    ls += __shfl_xor(ls, 32);
    m_out = mx; l_out = ls;
}
__device__ __forceinline__ void stage_o(const f32x16 (&o)[2], __attribute__((address_space(3))) float* stg, int lane) {
    const int r32 = lane & 31, hi = lane >> 5;
#pragma unroll
    for (int d0 = 0; d0 < 2; ++d0)
#pragma unroll
        for (int r = 0; r < 16; ++r) stg[crow(r, hi) * 68 + d0 * 32 + r32] = o[d0][r];
}
}

constexpr int D = 1024, NB = 2, T = 8192, MP = NB * T, DB = 128, MR = MP + DB  , MT = 16640  ;
constexpr int NH = 8, HD = 64, AW = 512, PW = 512, INW = 2048, FF = 2816, FF2 = 5632;
constexpr int NPAGES = 16, PSTATE = 15, NBLK_P = 32, NBLK_D = 8;
constexpr float RMS_EPS = 1e-6f;
constexpr int NWAVES = 8, NTHREADS = 512;

constexpr size_t O_YP = 0, O_YS = O_YP + (size_t)MP * D, O_KP = O_YS + (size_t)DB * D, O_VP = O_KP + (size_t)MP * AW, O_PP = O_VP + (size_t)MP * AW,
                 O_CP = O_PP + (size_t)NB * PSTATE * PW, O_KS = O_CP + (size_t)NB * 2 * FF2, O_VS = O_KS + (size_t)DB * AW, O_PS = O_VS + (size_t)DB * AW,
                 O_CS = O_PS + (size_t)DB * PSTATE * PW, O_END = O_CS + (size_t)DB * 2 * FF2;
static_assert(O_END == 36279296, "output size");

constexpr size_t MiB = 1u << 20;
constexpr size_t WS_CTL = 0, CTL_ZERO_BYTES = 1 * MiB;
constexpr size_t WS_WIN = 2 * MiB, WS_WO2 = 6 * MiB, WS_WUP = 8 * MiB, WS_WDN = 19 * MiB, WS_MOD = 25 * MiB, WS_ROPE = 29 * MiB, WS_KMD = 31 * MiB, WS_KMP = 33 * MiB;
constexpr size_t WS_XN = 34 * MiB, WS_PROJ = 67 * MiB, WS_QF = 197 * MiB, WS_A2 = 230 * MiB, WS_MIX = 263 * MiB, WS_X1 = 328 * MiB, WS_UP = 393 * MiB, WS_ACT = 751 * MiB, WS_FFN = 841 * MiB, WS_QB = 906 * MiB, WS_KB = 923 * MiB, WS_VB = 940 * MiB, WS_LIST = 957 * MiB, WS_COUNT = 965 * MiB, WS_PO = 966 * MiB, WS_PM = 1016 * MiB, WS_A2REF = 1020 * MiB, WS_END = 1037 * MiB;
static_assert(WS_WIN + (size_t)INW * D * 2 <= WS_WO2 && WS_WO2 + (size_t)D * D * 2 <= WS_WUP && WS_WUP + (size_t)FF2 * D * 2 <= WS_WDN && WS_WDN + (size_t)D * FF * 2 <= WS_MOD, "ws map 1");
static_assert(WS_MOD + (size_t)130 * 6 * D * 4 <= WS_ROPE && WS_ROPE + (size_t)T * 32 * 8 <= WS_KMD && WS_KMD + (size_t)DB * NBLK_D * AW * 4 <= WS_KMP && WS_KMP + (size_t)NB * NBLK_P * AW * 4 <= WS_XN, "ws map 2");
static_assert(WS_XN + (size_t)MT * D * 2 <= WS_PROJ && WS_PROJ + (size_t)MT * INW * 4 <= WS_QF && WS_QF + (size_t)MT * AW * 4 <= WS_A2 && WS_A2 + (size_t)MT * D * 2 <= WS_MIX, "ws map 3");
static_assert(WS_QB + (size_t)MT * AW * 2 <= WS_KB && WS_KB + (size_t)MT * AW * 2 <= WS_VB && WS_VB + (size_t)MT * AW * 2 <= WS_LIST && WS_LIST + (size_t)16 * 32 * 32 * 256 * 2 <= WS_COUNT && WS_COUNT + 16 * 32 * 32 * 4 <= WS_PO && WS_PO + (size_t)MP * NH * 3 * 64 * 2 <= WS_PM && WS_PM + (size_t)MP * NH * 3 * 8 <= WS_A2REF && WS_A2REF + (size_t)MP * AW * 2 <= WS_END, "ws map 5");
static_assert(WS_MIX + (size_t)MT * D * 4 <= WS_X1 && WS_X1 + (size_t)MT * D * 4 <= WS_UP && WS_UP + (size_t)MT * FF2 * 4 <= WS_ACT && WS_ACT + (size_t)MT * FF * 2 <= WS_FFN && WS_FFN + (size_t)MT * D * 4 <= WS_END, "ws map 4");
constexpr int CW_BAR = 4096;

constexpr int LDS_BYTES = 147456;
constexpr int LDSCTL_OFF = 146432, MISC_OFF = LDSCTL_OFF;

__device__ const double ROPE_INV[32] = {
1.00000000000000000000e+00, 7.49894209332455874417e-01, 5.62341325190349072827e-01, 4.21696503428582225581e-01, 3.16227766016837941176e-01, 2.37137370566165517349e-01, 1.77827941003892292526e-01, 1.33352143216332402753e-01,
1.00000000000000005551e-01, 7.49894209332455791150e-02, 5.62341325190349114460e-02, 4.21696503428582239459e-02, 3.16227766016837913421e-02, 2.37137370566165538166e-02, 1.77827941003892292526e-02, 1.33352143216332406223e-02,
1.00000000000000002082e-02, 7.49894209332455791150e-03, 5.62341325190349097113e-03, 4.21696503428582291501e-03, 3.16227766016837939442e-03, 2.37137370566165538166e-03, 1.77827941003892275179e-03, 1.33352143216332406223e-03,
1.00000000000000002082e-03, 7.49894209332455856203e-04, 5.62341325190349097113e-04, 4.21696503428582237290e-04, 3.16227766016837939442e-04, 2.37137370566165538166e-04, 1.77827941003892269758e-04, 1.33352143216332395381e-04};

struct Args { const void* in[23]; float* out; unsigned char* ws; int ph_lo, ph_hi; };

struct Ctx {
    LAS unsigned char* lds;
    int tid, lane, wave, gw, NGW, G;
    const float *x_prompt, *x_sample, *c_prompt, *c_sample, *cache_k, *cache_v; const int* page_table; const float *state_pool, *state_conv;
    const float *w_ada, *b_ada, *g_mix_pre, *g_mix_post, *w_in, *pool_w, *pool_scale, *w_out, *g_ffn_pre, *g_ffn_post, *w_up, *conv_w, *conv_b, *w_down;
    float* out;
    bf16 *WIN, *WO2, *WUP, *WDN, *XN, *A2, *ACT, *QB, *KB, *VB, *PO, *A2REF; unsigned short* LIST; int* COUNT; float2* PM; unsigned* ctl; float *MOD, *KMD, *KMP, *PROJ, *QF, *MIX, *X1, *UP, *FFN; float2* ROPE;
};

__device__ __forceinline__ float wave_sum(float v) {
#pragma unroll
    for (int o = 1; o < 64; o <<= 1) v += __shfl_xor(v, o);
    return v;
}
__device__ __forceinline__ float wave_max(float v) {
#pragma unroll
    for (int o = 1; o < 64; o <<= 1) v = fmaxf(v, __shfl_xor(v, o));
    return v;
}
__device__ __forceinline__ float silu_f(float v) { return v / (1.0f + __expf(-v)); }

__device__ __forceinline__ void dsincos(double a, double& s, double& c) {
    const double k = __builtin_rint(a * 0.63661977236758134308);
    double r = __builtin_fma(-k, 1.57079632679489655800e+00, a);
    r = __builtin_fma(-k, 6.12323399573676603587e-17, r);
    const double r2 = r * r;
    double sp = 1.0 / 6227020800.0;
    sp = sp * r2 - 1.0 / 39916800.0; sp = sp * r2 + 1.0 / 362880.0; sp = sp * r2 - 1.0 / 5040.0; sp = sp * r2 + 1.0 / 120.0; sp = sp * r2 - 1.0 / 6.0;
    const double sn = r + r * r2 * sp;
    double cp = -1.0 / 87178291200.0;
    cp = cp * r2 + 1.0 / 479001600.0; cp = cp * r2 - 1.0 / 3628800.0; cp = cp * r2 + 1.0 / 40320.0; cp = cp * r2 - 1.0 / 720.0; cp = cp * r2 + 1.0 / 24.0; cp = cp * r2 - 0.5;
    const double cn = 1.0 + r2 * cp;
    const int q = ((int)k) & 3;
    s = (q == 0) ? sn : (q == 1) ? cn : (q == 2) ? -sn : -cn;
    c = (q == 0) ? cn : (q == 1) ? -sn : (q == 2) ? -cn : sn;
}

__device__ __forceinline__ void transpose_item(const float* W, int ldw, bf16* WT, int ldt, int koff, int nblk, LAS float* scr, int item, int lane) {
    const int kb = item / nblk, nb = item % nblk, k0 = 64 * kb, n0 = 32 * nb;
#pragma unroll 8
    for (int i = 0; i < 32; ++i) { const int kk = 2 * i + (lane >> 5); scr[kk * 33 + (lane & 31)] = W[(size_t)(k0 + kk) * ldw + n0 + (lane & 31)]; }
    LDS_WAIT(); asm volatile("" ::: "memory");
    const int c = lane & 7;
#pragma unroll
    for (int j = 0; j < 4; ++j) { const int n = (lane >> 3) + 8 * j; const LAS float* s = scr + (8 * c) * 33 + n;
        v4u o; o.x = pk2(s[0 * 33], s[1 * 33]); o.y = pk2(s[2 * 33], s[3 * 33]); o.z = pk2(s[4 * 33], s[5 * 33]); o.w = pk2(s[6 * 33], s[7 * 33]);
        *(GAS v4u*)(WT + (size_t)(n0 + n) * ldt + koff + k0 + 8 * c) = o; }
    LDS_WAIT(); asm volatile("" ::: "memory");
}

__device__ __forceinline__ void p0_prologue(Ctx& F) {
    {
        LAS float* sl = (LAS float*)F.lds;
        for (int item = blockIdx.x; item < 120; item += F.G) {
            const int nch = item % 12, rg = item / 12;
            __syncthreads();
            for (int e = F.tid; e < 13 * D; e += NTHREADS) { const int rr = e >> 10, k = e & 1023, row = rg * 13 + rr;
                const float cv = (row < 2) ? F.c_prompt[row * D + k] : F.c_sample[(row - 2) * D + k]; sl[e] = silu_f(cv); }
            __syncthreads();
            const int n = nch * 512 + F.tid;
            float acc[13];
#pragma unroll
            for (int rr = 0; rr < 13; ++rr) acc[rr] = 0.f;
            for (int k = 0; k < D; ++k) { const float w = F.w_ada[(size_t)k * (6 * D) + n];
#pragma unroll
                for (int rr = 0; rr < 13; ++rr) acc[rr] += sl[rr * D + k] * w; }
            const float bv = F.b_ada[n];
#pragma unroll
            for (int rr = 0; rr < 13; ++rr) F.MOD[(size_t)(rg * 13 + rr) * (6 * D) + n] = acc[rr] + bv;
        }
        __syncthreads();
    }
    {
        LAS float* scr = (LAS float*)(F.lds + F.wave * 16384);
        constexpr int I_IN = (D / 64) * (INW / 32), I_O = (512 / 64) * (D / 32), I_UP = (D / 64) * (FF2 / 32), I_DN = (FF / 64) * (D / 32);
        constexpr int NITEMS = I_IN + I_O + I_UP + I_DN;
        for (int it = F.gw; it < NITEMS; it += F.NGW) {
            int r = it;
            if (r < I_IN) { transpose_item(F.w_in, INW, F.WIN, D, 0, INW / 32, scr, r, F.lane); continue; } r -= I_IN;
            if (r < I_O) { transpose_item(F.w_out + (size_t)512 * D, D, F.WO2, D, 512, D / 32, scr, r, F.lane); continue; } r -= I_O;
            if (r < I_UP) { transpose_item(F.w_up, FF2, F.WUP, D, 0, FF2 / 32, scr, r, F.lane); continue; } r -= I_UP;
            transpose_item(F.w_down, D, F.WDN, FF, 0, D / 32, scr, r, F.lane);
        }
    }
    for (int it = F.gw; it < D * 8; it += F.NGW) {
        const int n = it >> 3, kch = it & 7, k = kch * 64 + F.lane, g = k >> 7;
        const float* pw = F.pool_w + (size_t)k * 128;
        float acc = 0.f;
        for (int d = 0; d < 128; ++d) acc += pw[d] * (F.pool_scale[g * 128 + d] * F.w_out[(size_t)(g * 128 + d) * D + n]);
        F.WO2[(size_t)n * D + k] = (bf16)f2bf(acc);
    }
    for (int e = blockIdx.x * NTHREADS + F.tid; e < T * 32; e += F.G * NTHREADS) {
        const int pos = e >> 5, i = e & 31; double s, c; dsincos((double)pos * ROPE_INV[i], s, c);
        F.ROPE[e] = make_float2((float)c, (float)s);
    }
    {
        LAS f32x4* red = (LAS f32x4*)F.lds;
        const int ts = F.tid >> 7, c4 = F.tid & 127;
        for (int item = blockIdx.x; item < DB * NBLK_D; item += F.G) {
            const int b = item >> 3, n = item & 7;
            const int pg0 = F.page_table[b * NPAGES + 2 * n], pg1 = F.page_table[b * NPAGES + 2 * n + 1];
            f32x4 acc = (f32x4){0.f, 0.f, 0.f, 0.f};
#pragma unroll 8
            for (int itk = 0; itk < 64; ++itk) { const int tok = itk * 4 + ts; const int pg = (tok < 128) ? pg0 : pg1;
                acc += *(const f32x4*)(F.cache_k + ((size_t)pg * 128 + (tok & 127)) * AW + c4 * 4); }
            __syncthreads();
            red[ts * 128 + c4] = acc;
            __syncthreads();
            if (F.tid < 128) { const f32x4 s = (red[c4] + red[128 + c4]) + (red[256 + c4] + red[384 + c4]);
                *(f32x4*)(F.KMD + (size_t)item * AW + c4 * 4) = s * (1.0f / 256.0f); }
        }
        __syncthreads();
    }
}

__device__ __forceinline__ const float* x_row(const Ctx& F, int r) { return (r < MP) ? F.x_prompt + (size_t)r * D : F.x_sample + (size_t)(r - MP) * D; }
__device__ __forceinline__ int mod_row(int r) { return (r < MP) ? (r >> 13) : 2 + (r - MP); }

__device__ __forceinline__ void p1_norm_in(Ctx& F) {
    for (int r = F.gw; r < MT; r += F.NGW) {
        GAS unsigned long long* o8 = (GAS unsigned long long*)(F.XN + (size_t)r * D) + F.lane;
        if (r >= MR) {
#pragma unroll
            for (int j = 0; j < 4; ++j) o8[64 * j] = 0ull;
            GAS unsigned long long* a8 = (GAS unsigned long long*)(F.A2 + (size_t)r * D) + F.lane;
#pragma unroll
            for (int j = 0; j < 4; ++j) a8[64 * j] = 0ull;
            GAS unsigned long long* c8 = (GAS unsigned long long*)(F.ACT + (size_t)r * FF) + F.lane;
            for (int j = 0; j < FF / 256; ++j) c8[64 * j] = 0ull;
            continue;
        }
        const f32x4* xr = (const f32x4*)x_row(F, r) + F.lane;
        const float* mod = F.MOD + (size_t)mod_row(r) * (6 * D);
        f32x4 v[4]; float ss = 0.f;
#pragma unroll
        for (int j = 0; j < 4; ++j) { v[j] = xr[64 * j]; ss += (v[j].x * v[j].x + v[j].y * v[j].y) + (v[j].z * v[j].z + v[j].w * v[j].w); }
        const float rs = 1.0f / sqrtf(wave_sum(ss) * (1.0f / D) + RMS_EPS);
#pragma unroll
        for (int j = 0; j < 4; ++j) { const int c = 4 * F.lane + 256 * j;
            const f32x4 g = *(const f32x4*)(F.g_mix_pre + c), sh = *(const f32x4*)(mod + c), sc = *(const f32x4*)(mod + D + c);
            const f32x4 h = v[j] * rs * g * (sc + 1.0f) + sh;
            o8[64 * j] = (unsigned long long)pk2(h.x, h.y) | ((unsigned long long)pk2(h.z, h.w) << 32); }
    }
}

__device__ __forceinline__ void p3_post_proj(Ctx& F) {
    {
        LAS float* red = (LAS float*)F.lds;
        const int half = F.tid >> 8, pi = F.tid & 255, hh = pi >> 5, i = pi & 31, col = hh * 64 + i;
        for (int item = blockIdx.x; item < NB * NBLK_P; item += F.G) {
            const int bb = item >> 5, blk = item & 31;
            const int t0 = blk * 256 + half * 128; const size_t r0 = (size_t)bb * T + t0;
            float a1 = 0.f, a2 = 0.f;
#pragma unroll 4
            for (int rr = 0; rr < 128; ++rr) { const float* p = F.PROJ + (r0 + rr) * INW + 1024 + col; const float x1 = p[0], x2 = p[32];
                const float2 cs = F.ROPE[(t0 + rr) * 32 + i]; a1 += x1 * cs.x - x2 * cs.y; a2 += x2 * cs.x + x1 * cs.y; }
            __syncthreads();
            red[half * 512 + col] = a1; red[half * 512 + col + 32] = a2;
            __syncthreads();
            F.KMP[(size_t)item * AW + F.tid] = (red[F.tid] + red[512 + F.tid]) * (1.0f / 256.0f);
        }
        __syncthreads();
    }
    for (int r = F.gw; r < MR; r += F.NGW) {
        const bool dec = r >= MP; const int bb = dec ? (r - MP) : (r >> 13), t = dec ? 0 : (r & (T - 1)), pos = dec ? 2048 : t;
        const float* P = F.PROJ + (size_t)r * INW;
        float* kout = dec ? F.out + O_KS + (size_t)bb * AW : F.out + O_KP + (size_t)r * AW;
        float* vout = dec ? F.out + O_VS + (size_t)bb * AW : F.out + O_VP + (size_t)r * AW;
        float* qout = F.QF + (size_t)r * AW;
#pragma unroll
        for (int j = 0; j < 4; ++j) { const int pi = F.lane + 64 * j, hh = pi >> 5, i = pi & 31, col = hh * 64 + i;
            const float2 cs = F.ROPE[pos * 32 + i];
            const float q1 = P[512 + col], q2 = P[512 + col + 32], k1 = P[1024 + col], k2 = P[1024 + col + 32];
            const float qa = q1 * cs.x - q2 * cs.y, qb = q2 * cs.x + q1 * cs.y, ka = k1 * cs.x - k2 * cs.y, kb = k2 * cs.x + k1 * cs.y;
            qout[col] = qa; qout[col + 32] = qb; kout[col] = ka; kout[col + 32] = kb;
            F.QB[(size_t)r * AW + col] = (bf16)f2bf(qa * mb::C2); F.QB[(size_t)r * AW + col + 32] = (bf16)f2bf(qb * mb::C2);
            F.KB[(size_t)r * AW + col] = (bf16)f2bf(ka); F.KB[(size_t)r * AW + col + 32] = (bf16)f2bf(kb); }
#pragma unroll
        for (int j = 0; j < 2; ++j) { const f32x4 vv = *(const f32x4*)(P + 1536 + (F.lane + 64 * j) * 4); *(f32x4*)(vout + (F.lane + 64 * j) * 4) = vv;
            *(GAS unsigned long long*)(F.VB + (size_t)r * AW + (F.lane + 64 * j) * 4) = (unsigned long long)pk2(vv.x, vv.y) | ((unsigned long long)pk2(vv.z, vv.w) << 32); }
        const int c = F.lane * 8, g = c >> 7, w = 2 << g;
        const f32x4 u0 = *(const f32x4*)(P + c), u1 = *(const f32x4*)(P + c + 4);
        f32x4 s0 = u0, s1 = u1; int nterms;
        if (!dec) {
            nterms = (t + 1 < w) ? t + 1 : w;
            for (int s = 1; s < 16; ++s) if (s < nterms) { const float* pp = P - (size_t)s * INW + c; s0 += *(const f32x4*)pp; s1 += *(const f32x4*)(pp + 4); }
            if (t >= T - PSTATE) { float* po = F.out + O_PP + ((size_t)bb * PSTATE + (t - (T - PSTATE))) * PW + c; *(f32x4*)po = u0; *(f32x4*)(po + 4) = u1; }
        } else {
            nterms = w;
            const float* sp = F.state_pool + (size_t)bb * PSTATE * PW + c;
            for (int s = 1; s < 16; ++s) if (s < w) { const float* pp = sp + (size_t)(PSTATE - s) * PW; s0 += *(const f32x4*)pp; s1 += *(const f32x4*)(pp + 4); }
            float* po = F.out + O_PS + (size_t)bb * PSTATE * PW + c;
            for (int j = 0; j < PSTATE - 1; ++j) { *(f32x4*)(po + (size_t)j * PW) = *(const f32x4*)(sp + (size_t)(j + 1) * PW); *(f32x4*)(po + (size_t)j * PW + 4) = *(const f32x4*)(sp + (size_t)(j + 1) * PW + 4); }
            *(f32x4*)(po + (size_t)(PSTATE - 1) * PW) = u0; *(f32x4*)(po + (size_t)(PSTATE - 1) * PW + 4) = u1;
        }
        const float inv = 1.0f / (float)nterms;
        const f32x4 p0 = s0 * inv - u0, p1 = s1 * inv - u1;
        v4u o; o.x = pk2(p0.x, p0.y); o.y = pk2(p0.z, p0.w); o.z = pk2(p1.x, p1.y); o.w = pk2(p1.z, p1.w);
        *(GAS v4u*)(F.A2 + (size_t)r * D + c) = o;
    }
}

template <bool PROMPT_REF> __device__ __forceinline__ void p4_attention_naive(Ctx& F) {
    LAS float* qs = (LAS float*)(F.lds + F.wave * 8192);
    LAS float* S = qs + 64;
    const float* Kf = F.out + O_KP; const float* Vf = F.out + O_VP;
    const int I0 = PROMPT_REF ? 0 : MP * NH, NITEM = PROMPT_REF ? MP * NH : MP * NH + DB * NH;
    for (int idx = I0 + F.gw; idx < NITEM; idx += F.NGW) {
        const bool dec = idx >= MP * NH;
        const int r = dec ? MP + ((idx - MP * NH) >> 3) : (idx >> 3), hh = idx & 7;
        const int bb = dec ? (r - MP) : (r >> 13), t = dec ? 2048 : (r & (T - 1)), own = t >> 8;
        LDS_WAIT(); asm volatile("" ::: "memory");
        qs[F.lane] = F.QF[(size_t)r * AW + hh * HD + F.lane];
        LDS_WAIT(); asm volatile("" ::: "memory");
        float gate = -INFINITY;
        if (F.lane < own) {
            const float* km = dec ? F.KMD + ((size_t)bb * NBLK_D + F.lane) * AW + hh * HD : F.KMP + ((size_t)bb * NBLK_P + F.lane) * AW + hh * HD;
            float acc = 0.f;
            for (int d = 0; d < HD; ++d) acc += qs[d] * km[d];
            gate = acc;
        }
        int sel0 = 0, sel1 = 0, sel2 = 0, nsel = 0;
#pragma unroll
        for (int k = 0; k < 3; ++k) {
            const float m = wave_max(gate);
            if (m != -INFINITY) {
                const unsigned long long bal = __ballot(gate == m);
                const int ix = __ffsll((long long)bal) - 1;
                if (k == 0) sel0 = ix; else if (k == 1) sel1 = ix; else sel2 = ix;
                nsel = k + 1;
                if (F.lane == ix) gate = -INFINITY;
            }
        }
        const int nblk = nsel + 1;
        float lmax = -INFINITY;
        for (int j = 0; j < nblk; ++j) {
            const int blk = (j < nsel) ? ((j == 0) ? sel0 : (j == 1) ? sel1 : sel2) : own;
            if (dec && j == nsel) {
                const float* kp = F.out + O_KS + (size_t)bb * AW + hh * HD;
                float acc = 0.f;
                for (int d = 0; d < HD; ++d) acc += qs[d] * kp[d];
                const float s = acc * 0.125f;
                if (F.lane == 0) S[j * 256] = s;
                lmax = fmaxf(lmax, s);
                continue;
            }
            for (int rr = 0; rr < 4; ++rr) {
                const int kk = rr * 64 + F.lane, key = blk * 256 + kk;
                const float* kp;
                if (dec) { const int pg = F.page_table[bb * NPAGES + 2 * blk + (kk >> 7)]; kp = F.cache_k + ((size_t)pg * 128 + (kk & 127)) * AW + hh * HD; }
                else kp = Kf + ((size_t)bb * T + key) * AW + hh * HD;
                float acc = 0.f;
#pragma unroll
                for (int d4 = 0; d4 < 16; ++d4) { const f32x4 kv = *(const f32x4*)(kp + 4 * d4); const f32x4 qv = *(const LAS f32x4*)(qs + 4 * d4);
                    acc += (kv.x * qv.x + kv.y * qv.y) + (kv.z * qv.z + kv.w * qv.w); }
                float s = acc * 0.125f;
                if (key > t) s = -INFINITY;
                S[j * 256 + kk] = s;
                lmax = fmaxf(lmax, s);
            }
        }
        const float m = wave_max(lmax);
        LDS_WAIT(); asm volatile("" ::: "memory");
        const int nkeys = (dec ? nsel * 256 + 1 : nblk * 256);
        float lsum = 0.f;
        for (int e = F.lane; e < nkeys; e += 64) { const float p = __expf(S[e] - m); S[e] = p; lsum += p; }
        const float l = wave_sum(lsum);
        LDS_WAIT(); asm volatile("" ::: "memory");
        float acc = 0.f;
        for (int j = 0; j < nblk; ++j) {
            const int blk = (j < nsel) ? ((j == 0) ? sel0 : (j == 1) ? sel1 : sel2) : own;
            if (dec && j == nsel) { acc += S[j * 256] * F.out[O_VS + (size_t)bb * AW + hh * HD + F.lane]; continue; }
            int kend = 256;
            if (!dec && j == nsel) kend = t - own * 256 + 1;
            if (dec) {
                const int pg0 = F.page_table[bb * NPAGES + 2 * blk], pg1 = F.page_table[bb * NPAGES + 2 * blk + 1];
                for (int kk = 0; kk < 256; ++kk) { const int pg = (kk < 128) ? pg0 : pg1;
                    acc += S[j * 256 + kk] * F.cache_v[((size_t)pg * 128 + (kk & 127)) * AW + hh * HD + F.lane]; }
            } else {
                const float* vp = Vf + ((size_t)bb * T + blk * 256) * AW + hh * HD + F.lane;
                for (int kk = 0; kk < kend; ++kk) acc += S[j * 256 + kk] * vp[(size_t)kk * AW];
            }
        }
        if (PROMPT_REF) F.A2REF[(size_t)r * AW + hh * HD + F.lane] = (bf16)f2bf(acc / l);
        else F.A2[(size_t)r * D + 512 + hh * HD + F.lane] = (bf16)f2bf(acc / l);
    }
}

__device__ __forceinline__ void p6_mid_norm(Ctx& F) {
    for (int r = F.gw; r < MR; r += F.NGW) {
        const f32x4* xr = (const f32x4*)x_row(F, r) + F.lane;
        const f32x4* mr = (const f32x4*)(F.MIX + (size_t)r * D) + F.lane;
        const float* mod = F.MOD + (size_t)mod_row(r) * (6 * D);
        f32x4 v[4]; float ss = 0.f;
#pragma unroll
        for (int j = 0; j < 4; ++j) { v[j] = mr[64 * j]; ss += (v[j].x * v[j].x + v[j].y * v[j].y) + (v[j].z * v[j].z + v[j].w * v[j].w); }
        const float rs = 1.0f / sqrtf(wave_sum(ss) * (1.0f / D) + RMS_EPS);
        float ss2 = 0.f;
#pragma unroll
        for (int j = 0; j < 4; ++j) { const int c = 4 * F.lane + 256 * j;
            const f32x4 g = *(const f32x4*)(F.g_mix_post + c), gt = *(const f32x4*)(mod + 2 * D + c);
            v[j] = xr[64 * j] + gt * (v[j] * rs * g);
            *((f32x4*)(F.X1 + (size_t)r * D) + F.lane + 64 * j) = v[j];
            ss2 += (v[j].x * v[j].x + v[j].y * v[j].y) + (v[j].z * v[j].z + v[j].w * v[j].w); }
        const float rs2 = 1.0f / sqrtf(wave_sum(ss2) * (1.0f / D) + RMS_EPS);
        GAS unsigned long long* o8 = (GAS unsigned long long*)(F.XN + (size_t)r * D) + F.lane;
#pragma unroll
        for (int j = 0; j < 4; ++j) { const int c = 4 * F.lane + 256 * j;
            const f32x4 g = *(const f32x4*)(F.g_ffn_pre + c), sh = *(const f32x4*)(mod + 3 * D + c), sc = *(const f32x4*)(mod + 4 * D + c);
            const f32x4 h = v[j] * rs2 * g * (sc + 1.0f) + sh;
            o8[64 * j] = (unsigned long long)pk2(h.x, h.y) | ((unsigned long long)pk2(h.z, h.w) << 32); }
    }
}

__device__ __forceinline__ void p8_conv_act(Ctx& F) {
    for (int r = blockIdx.x; r < MR; r += F.G) {
        const bool dec = r >= MP; const int bb = dec ? (r - MP) : (r >> 13), t = dec ? 0 : (r & (T - 1));
        const float* u2 = F.UP + (size_t)r * FF2;
        const float* u1; const float* u0; bool z1 = false, z0 = false;
        if (dec) { u0 = F.state_conv + (size_t)bb * 2 * FF2; u1 = u0 + FF2; }
        else { u1 = u2 - FF2; u0 = u2 - 2 * (size_t)FF2; z1 = (t < 1); z0 = (t < 2); }
        for (int j = F.tid; j < FF; j += NTHREADS) {
            const float a2 = u2[j], g2 = u2[j + FF];
            const float a1 = z1 ? 0.f : u1[j], g1 = z1 ? 0.f : u1[j + FF];
            const float a0 = z0 ? 0.f : u0[j], g0 = z0 ? 0.f : u0[j + FF];
            const float ca = F.conv_b[j] + F.conv_w[j] * a0 + F.conv_w[FF2 + j] * a1 + F.conv_w[2 * FF2 + j] * a2;
            const float cg = F.conv_b[j + FF] + F.conv_w[j + FF] * g0 + F.conv_w[FF2 + j + FF] * g1 + F.conv_w[2 * FF2 + j + FF] * g2;
            F.ACT[(size_t)r * FF + j] = (bf16)f2bf(silu_f(ca) * cg);
            if (dec) { float* o = F.out + O_CS + (size_t)bb * 2 * FF2; o[j] = a1; o[j + FF] = g1; o[FF2 + j] = a2; o[FF2 + j + FF] = g2; }
            else if (t >= T - 2) { float* o = F.out + O_CP + ((size_t)bb * 2 + (t - (T - 2))) * FF2; o[j] = a2; o[j + FF] = g2; }
        }
    }
}

__device__ __forceinline__ void p10_final(Ctx& F) {
    for (int r = F.gw; r < MR; r += F.NGW) {
        const f32x4* fr = (const f32x4*)(F.FFN + (size_t)r * D) + F.lane;
        const f32x4* x1 = (const f32x4*)(F.X1 + (size_t)r * D) + F.lane;
        const float* mod = F.MOD + (size_t)mod_row(r) * (6 * D);
        float* yo = (r < MP) ? F.out + O_YP + (size_t)r * D : F.out + O_YS + (size_t)(r - MP) * D;
        f32x4 v[4]; float ss = 0.f;
#pragma unroll
        for (int j = 0; j < 4; ++j) { v[j] = fr[64 * j]; ss += (v[j].x * v[j].x + v[j].y * v[j].y) + (v[j].z * v[j].z + v[j].w * v[j].w); }
        const float rs = 1.0f / sqrtf(wave_sum(ss) * (1.0f / D) + RMS_EPS);
#pragma unroll
        for (int j = 0; j < 4; ++j) { const int c = 4 * F.lane + 256 * j;
            const f32x4 g = *(const f32x4*)(F.g_ffn_post + c), gt = *(const f32x4*)(mod + 5 * D + c);
            *((f32x4*)yo + F.lane + 64 * j) = x1[64 * j] + gt * (v[j] * rs * g); }
    }
}


__device__ __forceinline__ void s1a_select(Ctx& F) {
    const int lane = F.lane, wid = F.wave, r32 = lane & 31, hi = lane >> 5;
    LAS unsigned* cnt = (LAS unsigned*)(F.lds);
    LAS unsigned short* lst = (LAS unsigned short*)(F.lds + 128);
    for (int u = blockIdx.x; u < NB * NH * NBLK_P; u += F.G) {
        const int bh = u >> 5, Qb = u & 31, b = bh >> 3, h = bh & 7;
        if (Qb == 0) continue;
        __syncthreads();
        if (F.tid < 32) cnt[F.tid] = 0u;
        const size_t row = (size_t)b * T + Qb * 256 + wid * 32 + r32;
        mb::bf16x8 qr[4];
#pragma unroll
        for (int d0 = 0; d0 < 4; ++d0) qr[d0] = *(const mb::bf16x8*)(F.QB + row * AW + h * HD + 16 * d0 + 8 * hi);
        mb::f32x16 g = {};
#pragma unroll
        for (int d0 = 0; d0 < 4; ++d0) {
            const float* km = F.KMP + ((size_t)(b * NBLK_P + r32) * AW + h * HD + 16 * d0 + 8 * hi);
            const f32x4 a = *(const f32x4*)km, c = *(const f32x4*)(km + 4);
            const float x[8] = {a.x, a.y, a.z, a.w, c.x, c.y, c.z, c.w};
            mb::bf16x8 ah, al;
#pragma unroll
            for (int j = 0; j < 8; ++j) { const unsigned hb = f2bf(x[j]); const float rem = x[j] - __uint_as_float(hb << 16); ah[j] = (short)hb; al[j] = (short)f2bf(rem); }
            g = __builtin_amdgcn_mfma_f32_32x32x16_bf16(ah, qr[d0], g, 0, 0, 0);
            g = __builtin_amdgcn_mfma_f32_32x32x16_bf16(al, qr[d0], g, 0, 0, 0);
        }
        float v[16];
#pragma unroll
        for (int r = 0; r < 16; ++r) v[r] = (mb::crow(r, hi) < Qb) ? g[r] : -INFINITY;
        int sel[3];
#pragma unroll
        for (int k = 0; k < 3; ++k) {
            float bv = -INFINITY; int bi = 64;
#pragma unroll
            for (int r = 0; r < 16; ++r) if (v[r] > bv) { bv = v[r]; bi = mb::crow(r, hi); }
            const float pvv = __shfl_xor(bv, 32); const int pii = __shfl_xor(bi, 32);
            const bool tp = (pvv > bv) || (pvv == bv && pii < bi);
            const float wv = tp ? pvv : bv; const int wi = tp ? pii : bi;
            sel[k] = (wv == -INFINITY) ? -1 : wi;
#pragma unroll
            for (int r = 0; r < 16; ++r) if (mb::crow(r, hi) == wi) v[r] = -INFINITY;
        }
        __syncthreads();
        if (hi == 0) {
#pragma unroll
            for (int k = 0; k < 3; ++k) if (sel[k] >= 0) {
                const unsigned pos = __hip_atomic_fetch_add(cnt + sel[k], 1u, __ATOMIC_RELAXED, __HIP_MEMORY_SCOPE_WORKGROUP);
                lst[sel[k] * 256 + pos] = (unsigned short)((k << 8) | (wid * 32 + r32)); }
        }
        __syncthreads();
        { const int n = F.tid >> 4, part = F.tid & 15;
          if (n < Qb) { const size_t ub = ((size_t)(bh * 32 + n) * 32 + Qb);
              const LAS v4u* src = (const LAS v4u*)(lst + n * 256 + part * 16); GAS v4u* dst = (GAS v4u*)(F.LIST + ub * 256 + part * 16);
              dst[0] = src[0]; dst[1] = src[1];
              if (part == 0) F.COUNT[ub] = (int)cnt[n]; } }
    }
    __syncthreads();
}

__device__ __forceinline__ void s2_past(Ctx& F) {
    const int lane = F.lane, wid = F.wave, r32 = lane & 31, hi = lane >> 5;
    LAS unsigned char* misc = F.lds + mb::L_MISC;
    LAS int* PRE = (LAS int*)(misc + mb::M_PRE);
    LAS int* ROW = (LAS int*)(misc + mb::M_ROW);
    LAS int* WT = (LAS int*)(misc + mb::M_SCAL);
    const unsigned lds0 = (unsigned)(uintptr_t)F.lds;
    const mb::lds_cptr ldsc = (mb::lds_cptr)F.lds;
    {
        const int u = F.tid, n = u & 31; int L = 0; const int* cp = F.COUNT + (size_t)u * 32;
        for (int q = 0; q < 32; ++q) if (q > n) L += cp[q];
        int x = (L + 255) >> 8;
#pragma unroll
        for (int o = 1; o < 64; o <<= 1) { const int y = __shfl_up(x, o); if (lane >= o) x += y; }
        __syncthreads();
        if (lane == 63) WT[wid] = x;
        __syncthreads();
        int base = 0;
#pragma unroll
        for (int w = 0; w < 8; ++w) if (w < wid) base += WT[w];
        PRE[u + 1] = base + x; if (u == 0) PRE[0] = 0;
        __syncthreads();
    }
    const int NI = PRE[512];
    const int i0 = (int)((long long)NI * blockIdx.x / F.G), i1 = (int)((long long)NI * (blockIdx.x + 1) / F.G);
    int cur = -1;
    for (int it = i0; it < i1; ++it) {
        int lo = 0, hi_ = 512;
        while (hi_ - lo > 1) { const int mid = (lo + hi_) >> 1; if (PRE[mid] <= it) lo = mid; else hi_ = mid; }
        const int u = __builtin_amdgcn_readfirstlane(lo), c = it - PRE[u], bh = u >> 5, n = u & 31, b = bh >> 3, h = bh & 7;
        if (u != cur) {
            __syncthreads();
            mb::stage_kv(F.KB, F.VB, (size_t)b * T + n * 256, h * HD, lds0, wid, lane);
            if (wid == 0) {
                int x = (lane < 32 && lane > n) ? F.COUNT[(size_t)u * 32 + lane] : 0;
#pragma unroll
                for (int o = 1; o < 32; o <<= 1) { const int y = __shfl_up(x, o); if (lane >= o) x += y; }
                if (lane < 32) ROW[lane + 1] = x;
                if (lane == 0) ROW[0] = 0;
            }
            asm volatile("s_waitcnt vmcnt(0) lgkmcnt(0)" ::: "memory");
            __syncthreads();
            cur = u;
        }
        const int Ltot = ROW[32];
        const int e = c * 256 + wid * 32 + r32; const bool valid = e < Ltot; const int ee = valid ? e : c * 256;
        int ql = 0, qh = 32;
#pragma unroll
        for (int s = 0; s < 5; ++s) { const int mid = (ql + qh) >> 1; if (ROW[mid] <= ee) ql = mid; else qh = mid; }
        const int Qb = ql, idx = ee - ROW[Qb];
        const unsigned ent = F.LIST[((size_t)u * 32 + Qb) * 256 + idx];
        const int slot = (int)(ent >> 8), tl = (int)(ent & 255u);
        const size_t row = (size_t)b * T + Qb * 256 + tl;
        mb::bf16x8 qr[4];
#pragma unroll
        for (int d0 = 0; d0 < 4; ++d0) qr[d0] = *(const mb::bf16x8*)(F.QB + row * AW + h * HD + 16 * d0 + 8 * hi);
        float m, l; mb::f32x16 o[2];
        mb::attend256<false>(qr, ldsc, lds0, lane, 0, 3, m, l, o);
        const int pidx = valid ? (int)((row * NH + h) * 3 + slot) : -1;
        if (valid && hi == 0) F.PM[pidx] = make_float2(m, l);
        LAS float* stg = (LAS float*)(F.lds + mb::L_STG + wid * mb::STG_W);
        mb::stage_o(o, stg, lane);
        LDS_WAIT(); asm volatile("" ::: "memory");
#pragma unroll
        for (int i = 0; i < 4; ++i) { const int q = i * 8 + (lane >> 3), ch = lane & 7; const int pq = __shfl(pidx, q);
            if (pq >= 0) { const f32x4 a0 = *(const LAS f32x4*)(stg + q * 68 + ch * 8), a1 = *(const LAS f32x4*)(stg + q * 68 + ch * 8 + 4);
                v4u w; w.x = pk2(a0.x, a0.y); w.y = pk2(a0.z, a0.w); w.z = pk2(a1.x, a1.y); w.w = pk2(a1.z, a1.w);
                *(GAS v4u*)(F.PO + (size_t)pq * 64 + ch * 8) = w; } }
        LDS_WAIT(); asm volatile("" ::: "memory");
    }
    __syncthreads();
}

__device__ __forceinline__ void s1b_own_merge(Ctx& F) {
    const int lane = F.lane, wid = F.wave, r32 = lane & 31, hi = lane >> 5;
    const unsigned lds0 = (unsigned)(uintptr_t)F.lds;
    const mb::lds_cptr ldsc = (mb::lds_cptr)F.lds;
    LAS float* wsf = (LAS float*)(F.lds + mb::L_MISC + mb::M_WSF) + wid * 64;
    LAS float* stg = (LAS float*)(F.lds + mb::L_STG + wid * mb::STG_W);
    for (int u = blockIdx.x; u < NB * NH * NBLK_P; u += F.G) {
        const int bh = u >> 5, Qb = u & 31, b = bh >> 3, h = bh & 7;
        __syncthreads();
        mb::stage_kv(F.KB, F.VB, (size_t)b * T + Qb * 256, h * HD, lds0, wid, lane);
        const size_t row0 = (size_t)b * T + Qb * 256 + wid * 32;
        mb::bf16x8 qr[4];
#pragma unroll
        for (int d0 = 0; d0 < 4; ++d0) qr[d0] = *(const mb::bf16x8*)(F.QB + (row0 + r32) * AW + h * HD + 16 * d0 + 8 * hi);
        asm volatile("s_waitcnt vmcnt(0) lgkmcnt(0)" ::: "memory");
        __syncthreads();
        float m, l; mb::f32x16 o[2];
        mb::attend256<true>(qr, ldsc, lds0, lane, wid * 32 + r32, wid >> 1, m, l, o);
        if (hi == 0) { wsf[r32] = m; wsf[32 + r32] = l; }
        mb::stage_o(o, stg, lane);
        LDS_WAIT(); asm volatile("" ::: "memory");
        const int nv = Qb < 3 ? Qb : 3;
#pragma unroll
        for (int i = 0; i < 4; ++i) { const int q = i * 8 + (lane >> 3), ch = lane & 7; const size_t rq = row0 + q; const size_t pb = (rq * NH + h) * 3;
            const float mo = wsf[q], lo_ = wsf[32 + q];
            f32x4 a0 = *(const LAS f32x4*)(stg + q * 68 + ch * 8), a1 = *(const LAS f32x4*)(stg + q * 68 + ch * 8 + 4);
            float2 ml[3]; float M = mo;
#pragma unroll
            for (int s = 0; s < 3; ++s) if (s < nv) { ml[s] = F.PM[pb + s]; M = fmaxf(M, ml[s].x); }
            const float f = __builtin_amdgcn_exp2f(mo - M); float Ls = f * lo_; a0 = a0 * f; a1 = a1 * f;
#pragma unroll
            for (int s = 0; s < 3; ++s) if (s < nv) { const float fs = __builtin_amdgcn_exp2f(ml[s].x - M); Ls += fs * ml[s].y;
                const v4u w = *(const GAS v4u*)(F.PO + (pb + s) * 64 + ch * 8);
                a0.x += fs * __uint_as_float(w.x << 16); a0.y += fs * __uint_as_float(w.x & 0xffff0000u); a0.z += fs * __uint_as_float(w.y << 16); a0.w += fs * __uint_as_float(w.y & 0xffff0000u);
                a1.x += fs * __uint_as_float(w.z << 16); a1.y += fs * __uint_as_float(w.z & 0xffff0000u); a1.z += fs * __uint_as_float(w.w << 16); a1.w += fs * __uint_as_float(w.w & 0xffff0000u); }
            const float inv = 1.0f / Ls; a0 = a0 * inv; a1 = a1 * inv;
            v4u w; w.x = pk2(a0.x, a0.y); w.y = pk2(a0.z, a0.w); w.z = pk2(a1.x, a1.y); w.w = pk2(a1.z, a1.w);
            *(GAS v4u*)(F.A2 + rq * D + 512 + h * HD + ch * 8) = w; }
        LDS_WAIT(); asm volatile("" ::: "memory");
    }
    __syncthreads();
}

#ifndef PROBE_ATT
#define PROBE_ATT 0
#endif
__device__ __forceinline__ void probe_att_compare(Ctx& F) {
    float sd = 0.f, sr = 0.f;
    for (int r = F.gw; r < MP; r += F.NGW) {
        for (int j = 0; j < 8; ++j) { const int c = j * 64 + F.lane;
            const float a = __uint_as_float((unsigned)F.A2[(size_t)r * D + 512 + c] << 16), ref = __uint_as_float((unsigned)F.A2REF[(size_t)r * AW + c] << 16);
            sd += (a - ref) * (a - ref); sr += ref * ref; }
    }
    sd = wave_sum(sd); sr = wave_sum(sr);
    if (F.lane == 0) { atomicAdd((float*)(F.ctl + 16), sd); atomicAdd((float*)(F.ctl + 17), sr); }
}

constexpr int N_PHASES = 13;
__global__ void __launch_bounds__(NTHREADS, 2) fwd(Args args) {
    extern __shared__ __attribute__((aligned(16))) unsigned char lds[];
    Ctx F;
    F.lds = (LAS unsigned char*)lds;
    F.tid = threadIdx.x; F.lane = F.tid & 63; F.wave = __builtin_amdgcn_readfirstlane(F.tid >> 6);
    F.G = gridDim.x; F.gw = blockIdx.x * NWAVES + F.wave; F.NGW = F.G * NWAVES;
    F.x_prompt = (const float*)args.in[0]; F.x_sample = (const float*)args.in[1]; F.c_prompt = (const float*)args.in[2]; F.c_sample = (const float*)args.in[3];
    F.cache_k = (const float*)args.in[4]; F.cache_v = (const float*)args.in[5]; F.page_table = (const int*)args.in[6]; F.state_pool = (const float*)args.in[7]; F.state_conv = (const float*)args.in[8];
    F.w_ada = (const float*)args.in[9]; F.b_ada = (const float*)args.in[10]; F.g_mix_pre = (const float*)args.in[11]; F.g_mix_post = (const float*)args.in[12]; F.w_in = (const float*)args.in[13];
    F.pool_w = (const float*)args.in[14]; F.pool_scale = (const float*)args.in[15]; F.w_out = (const float*)args.in[16]; F.g_ffn_pre = (const float*)args.in[17]; F.g_ffn_post = (const float*)args.in[18];
    F.w_up = (const float*)args.in[19]; F.conv_w = (const float*)args.in[20]; F.conv_b = (const float*)args.in[21]; F.w_down = (const float*)args.in[22];
    F.out = args.out;
    unsigned char* ws = args.ws;
    F.WIN = (bf16*)(ws + WS_WIN); F.WO2 = (bf16*)(ws + WS_WO2); F.WUP = (bf16*)(ws + WS_WUP); F.WDN = (bf16*)(ws + WS_WDN);
    F.MOD = (float*)(ws + WS_MOD); F.ROPE = (float2*)(ws + WS_ROPE); F.KMD = (float*)(ws + WS_KMD); F.KMP = (float*)(ws + WS_KMP);
    F.XN = (bf16*)(ws + WS_XN); F.PROJ = (float*)(ws + WS_PROJ); F.QF = (float*)(ws + WS_QF); F.A2 = (bf16*)(ws + WS_A2); F.MIX = (float*)(ws + WS_MIX);
    F.QB = (bf16*)(ws + WS_QB); F.KB = (bf16*)(ws + WS_KB); F.VB = (bf16*)(ws + WS_VB); F.LIST = (unsigned short*)(ws + WS_LIST); F.COUNT = (int*)(ws + WS_COUNT); F.PO = (bf16*)(ws + WS_PO); F.PM = (float2*)(ws + WS_PM); F.A2REF = (bf16*)(ws + WS_A2REF); F.ctl = (unsigned*)(ws + WS_CTL);
    F.X1 = (float*)(ws + WS_X1); F.UP = (float*)(ws + WS_UP); F.ACT = (bf16*)(ws + WS_ACT); F.FFN = (float*)(ws + WS_FFN);

    volatile LAS unsigned* MISC = (volatile LAS unsigned*)(F.lds + MISC_OFF);
    for (int u = F.tid; u < (LDS_BYTES - LDSCTL_OFF) / 4; u += NTHREADS) ((LAS unsigned*)(F.lds + LDSCTL_OFF))[u] = 0u;
    __syncthreads();
    const int lo = args.ph_lo, hi = args.ph_hi;
    const bool multi = (hi - lo) > 1;
    XcdBarrier bar; bar.bar = (unsigned*)(ws + WS_CTL) + CW_BAR; bar.x = 0; bar.st = nullptr;
    if (multi) bar = xcd_barrier_post((unsigned*)(ws + WS_CTL) + CW_BAR, MISC + 8);
#define IN(k) (lo <= (k) && (k) < hi)
#define SEAM(k) do { if (IN(k) && IN((k) + 1)) xcd_barrier(bar); } while (0)

    if (IN(0)) { p0_prologue(F); } SEAM(0);
    if (IN(1)) { p1_norm_in(F); } SEAM(1);
    if (IN(2)) { pg8::Gemm g{F.XN, F.WIN, MT, INW, D}; pg8::StaticOrder S; S.init(MT, INW, F.G, (int)blockIdx.x); pg8::EpiF32 E{F.PROJ, INW, nullptr};
        pg8::gemm_phase<pg8::EpiF32, pg8::StaticOrder, PG8_ALIGN, PG8_SP2>(F.lds, g, S, E); } SEAM(2);
    if (IN(3)) { p3_post_proj(F); } SEAM(3);
    if (IN(4)) { s1a_select(F); p4_attention_naive<false>(F);
#if PROBE_ATT
        p4_attention_naive<true>(F);
#endif
    } SEAM(4);
    if (IN(5)) { s2_past(F); } SEAM(5);
    if (IN(6)) { s1b_own_merge(F); } SEAM(6);
    if (IN(7)) { pg8::Gemm g{F.A2, F.WO2, MT, D, D}; pg8::StaticOrder S; S.init(MT, D, F.G, (int)blockIdx.x); pg8::EpiF32 E{F.MIX, D, nullptr};
        pg8::gemm_phase<pg8::EpiF32, pg8::StaticOrder, PG8_ALIGN, PG8_SP2>(F.lds, g, S, E); } SEAM(7);
    if (IN(8)) { p6_mid_norm(F);
#if PROBE_ATT
        probe_att_compare(F);
#endif
    } SEAM(8);
    if (IN(9)) { pg8::Gemm g{F.XN, F.WUP, MT, FF2, D}; pg8::StaticOrder S; S.init(MT, FF2, F.G, (int)blockIdx.x); pg8::EpiF32 E{F.UP, FF2, nullptr};
        pg8::gemm_phase<pg8::EpiF32, pg8::StaticOrder, PG8_ALIGN, PG8_SP2>(F.lds, g, S, E); } SEAM(9);
    if (IN(10)) { p8_conv_act(F); } SEAM(10);
    if (IN(11)) { pg8::Gemm g{F.ACT, F.WDN, MT, D, FF}; pg8::StaticOrder S; S.init(MT, D, F.G, (int)blockIdx.x); pg8::EpiF32 E{F.FFN, D, nullptr};
        pg8::gemm_phase<pg8::EpiF32, pg8::StaticOrder, PG8_ALIGN, PG8_SP2>(F.lds, g, S, E); } SEAM(11);
    if (IN(12)) { p10_final(F);
#if PROBE_ATT
        if (blockIdx.x == 0 && F.tid == 0) { const float sd = __hip_atomic_load((float*)(F.ctl + 16), __ATOMIC_RELAXED, __HIP_MEMORY_SCOPE_AGENT), sr = __hip_atomic_load((float*)(F.ctl + 17), __ATOMIC_RELAXED, __HIP_MEMORY_SCOPE_AGENT);
            F.out[O_PP] += 100.0f * sqrtf(sd / fmaxf(sr, 1e-30f)); }
#endif
    }
#undef IN
#undef SEAM
}

#ifndef MK_ONE_LAUNCH
#define MK_ONE_LAUNCH 1
#endif
extern "C" void kernel_launch(void* const* d_in, const int* in_sizes, int n_in, void* d_out, int out_size, void* d_ws, size_t ws_size, hipStream_t stream) {
    static int grid = 0;
    if (grid == 0) {
        if (n_in != 23 || out_size != (int)O_END || ws_size < WS_END) { fprintf(stderr, "kernel_launch: unexpected shapes n_in %d out %d ws %zu\n", n_in, out_size, ws_size); grid = -1; return; }
        int dev = 0, cus = 0;
        if (hipGetDevice(&dev) != hipSuccess || hipDeviceGetAttribute(&cus, hipDeviceAttributeMultiprocessorCount, dev) != hipSuccess) { grid = -1; return; }
        if (hipFuncSetAttribute((const void*)fwd, hipFuncAttributeMaxDynamicSharedMemorySize, LDS_BYTES) != hipSuccess) { fprintf(stderr, "kernel_launch: hipFuncSetAttribute failed\n"); grid = -1; return; }
        int per_cu = 0;
        if (hipOccupancyMaxActiveBlocksPerMultiprocessor(&per_cu, (const void*)fwd, NTHREADS, LDS_BYTES) != hipSuccess || per_cu < 1) fprintf(stderr, "kernel_launch: occupancy query says %d\n", per_cu);
        (void)hipGetLastError();
        grid = cus;
    }
    if (grid < 0) return;
    (void)hipMemsetAsync((char*)d_ws + WS_CTL, 0, CTL_ZERO_BYTES, stream);
    Args a{};
    for (int i = 0; i < 23; ++i) a.in[i] = d_in[i];
    a.out = (float*)d_out; a.ws = (unsigned char*)d_ws;
#if MK_ONE_LAUNCH
    a.ph_lo = 0; a.ph_hi = N_PHASES;
    hipLaunchKernelGGL(fwd, dim3(grid), dim3(NTHREADS), LDS_BYTES, stream, a);
#else
    for (int p = 0; p < N_PHASES; ++p) { a.ph_lo = p; a.ph_hi = p + 1; hipLaunchKernelGGL(fwd, dim3(grid), dim3(NTHREADS), LDS_BYTES, stream, a); }
#endif
}
```

```cpp
#include <hip/hip_runtime.h>
#include <cstdio>
#include <cstdint>
namespace pg8 {
#define PG8_LAS __attribute__((address_space(3)))
typedef unsigned short bf16_t;
typedef short bf16x8 __attribute__((ext_vector_type(8)));
typedef float f32x4 __attribute__((ext_vector_type(4)));
typedef unsigned u32x4 __attribute__((ext_vector_type(4)));
constexpr int BM = 256, BK = 64, HALF = 128, HTB = HALF * BK * 2  , STAGE_BYTES = 8 * HTB, NXCD = 8, WGM = 8;

__host__ __device__ __forceinline__ int lds_byte(int r, int c) { const int st = (r >> 4) * 2 + (c >> 5), rr = r & 15, cc = c & 31, ob = rr * 64 + cc * 2; return st * 1024 + (ob ^ (((ob >> 9) & 1) << 5)); }
__host__ __device__ __forceinline__ void stage_rc(int b, int& R, int& C) { const int st = b / 1024, sb = b % 1024, swz = sb ^ (((sb >> 9) & 1) << 5); R = (st >> 1) * 16 + swz / 64; C = (st & 1) * 32 + (swz % 64) / 2; }
__host__ __device__ __forceinline__ int perm32(int rho) { const int n = rho >> 4, i = rho & 15; return 8 * (i >> 2) + 4 * n + (i & 3); }

struct Unit { int pm, pn; };
struct Gemm { const bf16_t* A; const bf16_t* Bt; int M, N, K; };

struct StaticOrder {
    int nM, nN, nwg, G, c;
    __host__ __device__ void init(int M, int N, int G_, int c_) { nM = M / BM; nN = N / BM; nwg = nM * nN; G = G_; c = c_; }
    __host__ __device__ bool next(int i, Unit& u) const {
        const long L = (long)i * G + c; if (L >= nwg) return false;
        int wgid = (int)L; { const int q = nwg / NXCD, r = nwg % NXCD, xcd = wgid % NXCD, off = wgid / NXCD; wgid = (xcd < r ? xcd * (q + 1) : r * (q + 1) + (xcd - r) * q) + off; }
        const int nig = WGM * nN, gid = wgid / nig, fm = gid * WGM, gsz = (nM - fm) < WGM ? (nM - fm) : WGM;
        u.pm = fm + ((wgid % nig) % gsz); u.pn = (wgid % nig) / gsz; return true;
    }
    __device__ __forceinline__ void a_ready(const Unit&) const {}
    __device__ __forceinline__ void done(const Unit&) const {}
};

__device__ __forceinline__ unsigned cvt_pk_bf16(float lo, float hi) { unsigned r; asm volatile("v_cvt_pk_bf16_f32 %0, %1, %2" : "=v"(r) : "v"(lo), "v"(hi)); return r; }
typedef float f32x2 __attribute__((ext_vector_type(2)));
__device__ __forceinline__ f32x2 gelu_pk(f32x2 v) {
    const f32x2 av = __builtin_elementwise_abs(v), d = av * 0.2316418882f + 1.0f;
    f32x2 t; t.x = __builtin_amdgcn_rcpf(d.x); t.y = __builtin_amdgcn_rcpf(d.y);
    f32x2 q = t * 0.5307027145f + (-0.7265760135f); q = q * t + 0.7107068705f; q = q * t + (-0.142248368f); q = q * t + 0.127414796f; q = q * t;
    const f32x2 s = (v * v) * (-0.72134752044f);
    f32x2 e; e.x = __builtin_amdgcn_exp2f(s.x); e.y = __builtin_amdgcn_exp2f(s.y);
    const f32x2 m = v * (q * e), r = v - m;
    f32x2 o; o.x = v.x < 0.f ? m.x : r.x; o.y = v.y < 0.f ? m.y : r.y; return o;
}

template <int ACT  > struct EpiBf16 {
    static constexpr bool PERM = true, AFTER_DRAIN = false; static_assert(ACT == 0 || ACT == 1, "EpiBf16: ACT is 0 (none) or 1 (gelu_pk)");
    bf16_t* O; int ldc; const float* bias; int split_cols; size_t split_stride; float scale0;
    __device__ __forceinline__ void operator()(const f32x4 (&acc)[2][2][4][2], const Unit& u, int wr, int wc, int fr, int fq) const {
        const int row0 = u.pm * BM + wr * 64 + fr; int colt = u.pn * BM; bf16_t* base = O;
        float sc = 1.f; if (split_cols) { const int t = colt / split_cols; base += (size_t)t * split_stride; colt -= t * split_cols; if (t == 0) sc = scale0; }
        const int col0 = colt + wc * 32 + 8 * fq, bcol0 = u.pn * BM + wc * 32 + 8 * fq;
        f32x4 bv[2][2];
#pragma unroll
        for (int bj = 0; bj < 2; ++bj)
#pragma unroll
            for (int n = 0; n < 2; ++n) bv[bj][n] = bias ? *(const f32x4*)(bias + bcol0 + bj * HALF + 4 * n) : (f32x4){0.f, 0.f, 0.f, 0.f};
#pragma unroll
        for (int ai = 0; ai < 2; ++ai)
#pragma unroll
            for (int m = 0; m < 4; ++m) { bf16_t* rowp = base + (size_t)(row0 + ai * HALF + m * 16) * ldc + col0;
#pragma unroll
                for (int bj = 0; bj < 2; ++bj) { f32x4 v0 = acc[ai][bj][m][0] + bv[bj][0], v1 = acc[ai][bj][m][1] + bv[bj][1];
                    if (ACT == 1) { f32x2 a = gelu_pk((f32x2){v0[0], v0[1]}), b = gelu_pk((f32x2){v0[2], v0[3]}), c = gelu_pk((f32x2){v1[0], v1[1]}), d = gelu_pk((f32x2){v1[2], v1[3]});
                        v0 = (f32x4){a.x, a.y, b.x, b.y}; v1 = (f32x4){c.x, c.y, d.x, d.y}; }
                    v0 = v0 * sc; v1 = v1 * sc; u32x4 w; w.x = cvt_pk_bf16(v0[0], v0[1]); w.y = cvt_pk_bf16(v0[2], v0[3]); w.z = cvt_pk_bf16(v1[0], v1[1]); w.w = cvt_pk_bf16(v1[2], v1[3]);
                    *(u32x4*)(rowp + bj * HALF) = w; } }
    }
};

struct PanelStats {
    unsigned* xbuf;
    unsigned* cnt;
    unsigned* tmo;
    int ntn; float eps;
    unsigned code;
    __device__ __forceinline__ bool run(const f32x4 (&v)[2][2][4][2], const Unit& u, int wr, int wc, int fr, int fq, PG8_LAS unsigned char* lds, int wid, int lane) const {
        typedef float f32x2v __attribute__((ext_vector_type(2)));
        PG8_LAS f32x2v* P = (PG8_LAS f32x2v*)lds;
        PG8_LAS f32x2v* S = (PG8_LAS f32x2v*)(lds + 8192);
        PG8_LAS unsigned* flag = (PG8_LAS unsigned*)(lds + 8192 + 2048);
#pragma unroll
        for (int ai = 0; ai < 2; ++ai)
#pragma unroll
            for (int m = 0; m < 4; ++m) {
                float s = 0.f;
#pragma unroll
                for (int bj = 0; bj < 2; ++bj)
#pragma unroll
                    for (int n = 0; n < 2; ++n) { const f32x4 x = v[ai][bj][m][n]; s += (x[0] + x[1]) + (x[2] + x[3]); }
                s += __shfl_xor(s, 16); s += __shfl_xor(s, 32);
                const float mw = s * (1.0f / 64.0f); float q = 0.f;
#pragma unroll
                for (int bj = 0; bj < 2; ++bj)
#pragma unroll
                    for (int n = 0; n < 2; ++n) { const f32x4 d = v[ai][bj][m][n] - mw; q += (d[0] * d[0] + d[1] * d[1]) + (d[2] * d[2] + d[3] * d[3]); }
                q += __shfl_xor(q, 16); q += __shfl_xor(q, 32);
                if (fq == 0) P[(ai * HALF + wr * 64 + m * 16 + fr) * 4 + wc] = (f32x2v){mw, q};
            }
        asm volatile("s_waitcnt lgkmcnt(0)" ::: "memory"); __builtin_amdgcn_s_barrier(); asm volatile("" ::: "memory");
#if defined(BROKEN_EXCHANGE_NO_WAIT)
#warning BROKEN CONTROL BUILD: the row-statistics exchange does not wait; results are wrong by design
        if (blockIdx.x >= 64) { const long long t0_ = clock64(); while (clock64() - t0_ < 60000) __builtin_amdgcn_s_sleep(8); }
#endif
        const int row = wid * 32 + (lane & 31);
        if (lane < 32) {
            const f32x2v a = P[row * 4 + 0], b = P[row * 4 + 1], c = P[row * 4 + 2], d = P[row * 4 + 3];
            const float mt = (a.x + b.x + c.x + d.x) * 0.25f;
            const float da = a.x - mt, db = b.x - mt, dc = c.x - mt, dd = d.x - mt;
            const float m2 = (a.y + b.y) + (c.y + d.y) + 64.0f * ((da * da + db * db) + (dc * dc + dd * dd));
            unsigned long long* slot = (unsigned long long*)xbuf + ((size_t)(u.pm * BM + row) * 4 + u.pn);
            __hip_atomic_store(slot, ((unsigned long long)__float_as_uint(m2) << 32) | __float_as_uint(mt), __ATOMIC_RELAXED, __HIP_MEMORY_SCOPE_AGENT);
        }
        asm volatile("s_waitcnt vmcnt(0)" ::: "memory");
        if (lane == 0) __hip_atomic_fetch_add(cnt + 64 * u.pm, 1u, __ATOMIC_RELAXED, __HIP_MEMORY_SCOPE_AGENT);
        if (wid == 0) {
            bool dead = false; const unsigned long long t0 = __builtin_amdgcn_s_memrealtime(); const unsigned want = 8u * (unsigned)ntn;
            for (;;) {
#if defined(BROKEN_EXCHANGE_NO_WAIT)
                break;
#endif
                if ((unsigned)__builtin_amdgcn_readfirstlane(__hip_atomic_load(cnt + 64 * u.pm, __ATOMIC_RELAXED, __HIP_MEMORY_SCOPE_AGENT)) >= want) break;
                if (__builtin_amdgcn_s_memrealtime() - t0 > 2000000ull) {
                    if (lane == 0) { unsigned expect = 0u; __hip_atomic_compare_exchange_strong(tmo + 1, &expect, code | (unsigned)(u.pm & 0xff), __ATOMIC_RELAXED, __ATOMIC_RELAXED, __HIP_MEMORY_SCOPE_AGENT);
                                     __hip_atomic_store(tmo, 1u, __ATOMIC_RELAXED, __HIP_MEMORY_SCOPE_AGENT); }
                    dead = true; break; }
                __builtin_amdgcn_s_sleep(2);
            }
            __builtin_amdgcn_fence(__ATOMIC_ACQUIRE, "agent");
            if (lane == 0) flag[0] = dead ? 1u : 0u;
        }
        asm volatile("s_waitcnt vmcnt(0) lgkmcnt(0)" ::: "memory"); __builtin_amdgcn_s_barrier(); asm volatile("" ::: "memory");
        const bool bad = flag[0] != 0u;
        if (lane < 32) {
            const unsigned long long* slot = (const unsigned long long*)xbuf + (size_t)(u.pm * BM + row) * 4; float mt[4], m2[4]; float ms = 0.f;
#pragma unroll
            for (int t = 0; t < 4; ++t) { if (t < ntn) { const unsigned long long w = __hip_atomic_load(slot + t, __ATOMIC_RELAXED, __HIP_MEMORY_SCOPE_AGENT); mt[t] = __uint_as_float((unsigned)w); m2[t] = __uint_as_float((unsigned)(w >> 32)); } else { mt[t] = 0.f; m2[t] = 0.f; } ms += mt[t]; }
            const float mean = ms / (float)ntn; float q = 0.f;
#pragma unroll
            for (int t = 0; t < 4; ++t) if (t < ntn) { const float dm = mt[t] - mean; q += m2[t] + 256.0f * dm * dm; }
            S[row] = (f32x2v){mean, 1.0f / sqrtf(q / (256.0f * (float)ntn) + eps)};
        }
        asm volatile("s_waitcnt lgkmcnt(0)" ::: "memory"); __builtin_amdgcn_s_barrier(); asm volatile("" ::: "memory");
        return bad;
    }
};
struct EpiLnRes {
    static constexpr bool PERM = false, AFTER_DRAIN = true;
    const float* base; float* out; int ldc; const float* bias; PanelStats st; unsigned poison;
    __device__ __forceinline__ void fused(f32x4 (&acc)[2][2][4][2], const Unit& u, int wr, int wc, int fr, int fq, PG8_LAS unsigned char* lds, int wid, int lane) const {
        typedef float f32x2v __attribute__((ext_vector_type(2)));
        const PG8_LAS f32x2v* S = (const PG8_LAS f32x2v*)(lds + 8192);
        const int col0 = u.pn * BM + wc * 32 + 4 * fq;
#pragma unroll
        for (int bj = 0; bj < 2; ++bj)
#pragma unroll
            for (int n = 0; n < 2; ++n) { const f32x4 bv = bias ? *(const f32x4*)(bias + col0 + bj * HALF + n * 16) : (f32x4){0.f, 0.f, 0.f, 0.f};
#pragma unroll
                for (int ai = 0; ai < 2; ++ai)
#pragma unroll
                    for (int m = 0; m < 4; ++m) acc[ai][bj][m][n] += bv; }
        f32x4 pre[4][2][2];
#pragma unroll
        for (int m = 0; m < 4; ++m) { const size_t off = (size_t)(u.pm * BM + wr * 64 + m * 16 + fr) * ldc + col0;
#pragma unroll
            for (int bj = 0; bj < 2; ++bj)
#pragma unroll
                for (int n = 0; n < 2; ++n) pre[m][bj][n] = *(const f32x4*)(base + off + bj * HALF + n * 16); }
        const bool bad = st.run(acc, u, wr, wc, fr, fq, lds, wid, lane) || poison != 0u;
        const float qnan = __builtin_nanf("");
#pragma unroll
        for (int ai = 0; ai < 2; ++ai)
#pragma unroll
            for (int m = 0; m < 4; ++m) { const int r = ai * HALF + wr * 64 + m * 16 + fr; const f32x2v sr = S[r]; const size_t off = (size_t)(u.pm * BM + r) * ldc + col0;
#pragma unroll
                for (int bj = 0; bj < 2; ++bj)
#pragma unroll
                    for (int n = 0; n < 2; ++n) { const f32x4 bs = ai == 0 ? pre[m][bj][n] : *(const f32x4*)(base + off + bj * HALF + n * 16); f32x4 o = bs + (acc[ai][bj][m][n] - sr.x) * sr.y;
                        if (bad) o = (f32x4){qnan, qnan, qnan, qnan}; *(f32x4*)(out + off + bj * HALF + n * 16) = o; }
                if (m & 1) asm volatile("" ::: "memory"); }
    }
};
struct EpiLnResLn {
    static constexpr bool PERM = false, AFTER_DRAIN = true;
    const float* base; float* out; bf16_t* xn; int ldc; const float* bias; PanelStats st1, st2; unsigned poison;
    __device__ __forceinline__ void fused(f32x4 (&acc)[2][2][4][2], const Unit& u, int wr, int wc, int fr, int fq, PG8_LAS unsigned char* lds, int wid, int lane) const {
        typedef float f32x2v __attribute__((ext_vector_type(2))); typedef unsigned u32x2v __attribute__((ext_vector_type(2)));
        const PG8_LAS f32x2v* S = (const PG8_LAS f32x2v*)(lds + 8192);
        const int col0 = u.pn * BM + wc * 32 + 4 * fq;
#pragma unroll
        for (int bj = 0; bj < 2; ++bj)
#pragma unroll
            for (int n = 0; n < 2; ++n) { const f32x4 bv = bias ? *(const f32x4*)(bias + col0 + bj * HALF + n * 16) : (f32x4){0.f, 0.f, 0.f, 0.f};
#pragma unroll
                for (int ai = 0; ai < 2; ++ai)
#pragma unroll
                    for (int m = 0; m < 4; ++m) acc[ai][bj][m][n] += bv; }
        bool bad = st1.run(acc, u, wr, wc, fr, fq, lds, wid, lane) || poison != 0u;
        const float qnan = __builtin_nanf("");
#pragma unroll
        for (int ai = 0; ai < 2; ++ai)
#pragma unroll
            for (int m = 0; m < 4; ++m) { const int r = ai * HALF + wr * 64 + m * 16 + fr; const f32x2v sr = S[r]; const size_t off = (size_t)(u.pm * BM + r) * ldc + col0;
#pragma unroll
                for (int bj = 0; bj < 2; ++bj)
#pragma unroll
                    for (int n = 0; n < 2; ++n) { const f32x4 bs = *(const f32x4*)(base + off + bj * HALF + n * 16); acc[ai][bj][m][n] = bs + (acc[ai][bj][m][n] - sr.x) * sr.y; }
                asm volatile("" : "+v"(acc[ai][0][m][0]), "+v"(acc[ai][0][m][1]), "+v"(acc[ai][1][m][0]), "+v"(acc[ai][1][m][1]));
                if (m & 1) asm volatile("" ::: "memory"); }
        const bool bad1 = bad;
        bad = st2.run(acc, u, wr, wc, fr, fq, lds, wid, lane) || bad;
#pragma unroll
        for (int ai = 0; ai < 2; ++ai)
#pragma unroll
            for (int m = 0; m < 4; ++m) { const int r = ai * HALF + wr * 64 + m * 16 + fr; const f32x2v sr = S[r]; const size_t off = (size_t)(u.pm * BM + r) * ldc + col0;
#pragma unroll
                for (int bj = 0; bj < 2; ++bj)
#pragma unroll
                    for (int n = 0; n < 2; ++n) { const f32x4 x1 = acc[ai][bj][m][n]; *(f32x4*)(out + off + bj * HALF + n * 16) = bad1 ? (f32x4){qnan, qnan, qnan, qnan} : x1;
                        const f32x4 o = (x1 - sr.x) * sr.y; u32x2v w; w.x = cvt_pk_bf16(o[0], o[1]); w.y = cvt_pk_bf16(o[2], o[3]);
                        if (bad) { w.x = 0x7fc07fc0u; w.y = 0x7fc07fc0u; } *(u32x2v*)(xn + off + bj * HALF + n * 16) = w; }
                asm volatile("" ::: "memory"); }
    }
};

template <class Epi, class Sched, bool ALIGN_EPI = false, bool SP2 = false>
__device__ __forceinline__ void gemm_phase(PG8_LAS unsigned char* lds, const Gemm g, const Sched& S, const Epi& E) {
    const int tid = threadIdx.x, wid = __builtin_amdgcn_readfirstlane(tid >> 6), lane = tid & 63, wr = wid >> 2, wc = wid & 3, fr = lane & 15, fq = lane >> 4;
    const int K = g.K, nt = K / BK;
    unsigned voffA[2], voffB[2];
#pragma unroll
    for (int i = 0; i < 2; ++i) { int R, C; stage_rc(tid * 16 + i * 8192, R, C); const int Rb = Epi::PERM ? ((R & ~31) + perm32(R & 31)) : R;
        voffA[i] = (unsigned)(R * K + C) * 2u; voffB[i] = (unsigned)(Rb * K + C) * 2u; }
    const size_t kstep = (size_t)(BK * 2);
    const size_t hstep = (size_t)HALF * K * 2;
    const size_t tstep = 2 * hstep;
    const unsigned ldsw = (unsigned)wid * 1024u;
    const int aoff = lds_byte(wr * 64 + fr, fq * 8), boff = lds_byte(wc * 32 + fr, fq * 8);
#define PG8_SA(b, h) (((b) * 2 + (h)) * HTB)
#define PG8_SB(b, h) ((4 + (b) * 2 + (h)) * HTB)
#define PG8_STAGE(bufoff, gbase, voff) do { _Pragma("unroll") for (int _i = 0; _i < 2; ++_i) \
        __builtin_amdgcn_global_load_lds((const unsigned*)((const char*)(gbase) + (voff)[_i]), (PG8_LAS unsigned*)(lds + (bufoff) + ldsw + _i * 8192), 16, 0, 0); } while (0)
#define PG8_LDA(dst, b, h) do { _Pragma("unroll") for (int m = 0; m < 4; ++m) _Pragma("unroll") for (int k = 0; k < 2; ++k) dst[m][k] = *(const PG8_LAS bf16x8*)(lds + PG8_SA(b, h) + aoff + m * 2048 + k * 1024); } while (0)
#define PG8_LDB(dst, b, h) do { _Pragma("unroll") for (int n = 0; n < 2; ++n) _Pragma("unroll") for (int k = 0; k < 2; ++k) dst[n][k] = *(const PG8_LAS bf16x8*)(lds + PG8_SB(b, h) + boff + n * 2048 + k * 1024); } while (0)
#define PG8_MMA(ai, bj, At, Bt) do { __builtin_amdgcn_s_setprio(1); _Pragma("unroll") for (int m = 0; m < 4; ++m) _Pragma("unroll") for (int n = 0; n < 2; ++n) _Pragma("unroll") for (int k = 0; k < 2; ++k) \
        acc[ai][bj][m][n] = __builtin_amdgcn_mfma_f32_16x16x32_bf16(Bt[n][k], At[m][k], acc[ai][bj][m][n], 0, 0, 0); __builtin_amdgcn_s_setprio(0); } while (0)
#define PG8_WAIT_V(n) asm volatile("s_waitcnt vmcnt(" #n ")" ::: "memory")
#define PG8_WAIT_L(n) asm volatile("s_waitcnt lgkmcnt(" #n ")" ::: "memory")
#define PG8_BAR __builtin_amdgcn_s_barrier()
#define PG8_SCHED __builtin_amdgcn_sched_barrier(0)
    Unit cur, nxt; int ui = 0;
    if (!S.next(0, cur)) return;
    f32x4 acc[2][2][4][2];
#pragma unroll
    for (int a = 0; a < 2; ++a)
#pragma unroll
        for (int b = 0; b < 2; ++b)
#pragma unroll
            for (int m = 0; m < 4; ++m)
#pragma unroll
                for (int n = 0; n < 2; ++n) acc[a][b][m][n] = (f32x4){0.f, 0.f, 0.f, 0.f};
    bf16x8 At[4][2], B0[2][2], B1[2][2];
    const char* cA = (const char*)g.A + (size_t)cur.pm * tstep; const char* cB = (const char*)g.Bt + (size_t)cur.pn * tstep;
    S.a_ready(cur);
    if constexpr (SP2) {
        PG8_STAGE(PG8_SB(0, 0), cB, voffB); PG8_STAGE(PG8_SB(0, 1), cB + hstep, voffB); PG8_STAGE(PG8_SA(0, 0), cA, voffA); PG8_STAGE(PG8_SA(0, 1), cA + hstep, voffA);
        if (wr == 1) PG8_BAR;
        PG8_WAIT_V(2); PG8_BAR;
        PG8_STAGE(PG8_SB(1, 0), cB + kstep, voffB); PG8_STAGE(PG8_SA(1, 0), cA + kstep, voffA); PG8_STAGE(PG8_SB(1, 1), cB + hstep + kstep, voffB);
        PG8_WAIT_V(6); PG8_BAR;
    } else {
        PG8_STAGE(PG8_SB(0, 0), cB, voffB); PG8_STAGE(PG8_SA(0, 0), cA, voffA); PG8_STAGE(PG8_SB(0, 1), cB + hstep, voffB); PG8_STAGE(PG8_SA(0, 1), cA + hstep, voffA);
        if (wr == 1) PG8_BAR;
        PG8_WAIT_V(4); PG8_BAR;
        PG8_STAGE(PG8_SB(1, 0), cB + kstep, voffB); PG8_STAGE(PG8_SA(1, 0), cA + kstep, voffA); PG8_STAGE(PG8_SB(1, 1), cB + hstep + kstep, voffB);
        PG8_WAIT_V(6); PG8_BAR;
    }
    for (;;) {
        const bool has_next = S.next(ui + 1, nxt);
        const char* nA = has_next ? (const char*)g.A + (size_t)nxt.pm * tstep : cA; const char* nB = has_next ? (const char*)g.Bt + (size_t)nxt.pn * tstep : cB;
        for (int t = 0; t < nt; t += 2) {
            const bool last = (t == nt - 2);
            const char* a1 = cA + (size_t)(t + 1) * kstep;
            const char* a2 = last ? nA : cA + (size_t)(t + 2) * kstep; const char* b2 = last ? nB : cB + (size_t)(t + 2) * kstep;
            const char* a3 = a2 + kstep; const char* b3 = b2 + kstep;
            if (last && has_next) S.a_ready(nxt);
            if constexpr (SP2) {
            PG8_LDB(B0, 0, 0); PG8_LDB(B1, 0, 1); PG8_SCHED; PG8_LDA(At, 0, 0); PG8_STAGE(PG8_SA(1, 1), a1 + hstep, voffA);
            PG8_WAIT_V(8); PG8_WAIT_L(0); PG8_BAR; PG8_MMA(0, 0, At, B0); PG8_MMA(0, 1, At, B1); PG8_BAR; PG8_SCHED;
            PG8_LDA(At, 0, 1); PG8_STAGE(PG8_SB(0, 0), b2, voffB); PG8_STAGE(PG8_SB(0, 1), b2 + hstep, voffB); PG8_STAGE(PG8_SA(0, 0), a2, voffA);
            PG8_WAIT_V(8); PG8_WAIT_L(0); PG8_BAR; PG8_MMA(1, 0, At, B0); PG8_MMA(1, 1, At, B1); PG8_BAR; PG8_SCHED;
            PG8_LDB(B0, 1, 0); PG8_LDB(B1, 1, 1); PG8_SCHED; PG8_LDA(At, 1, 0); PG8_STAGE(PG8_SA(0, 1), a2 + hstep, voffA);
            PG8_WAIT_V(8); PG8_WAIT_L(0); PG8_BAR; PG8_MMA(0, 0, At, B0); PG8_MMA(0, 1, At, B1); PG8_BAR; PG8_SCHED;
            PG8_LDA(At, 1, 1); PG8_STAGE(PG8_SB(1, 0), b3, voffB); PG8_STAGE(PG8_SB(1, 1), b3 + hstep, voffB); PG8_STAGE(PG8_SA(1, 0), a3, voffA);
            PG8_WAIT_V(8); PG8_WAIT_L(0); PG8_BAR; PG8_MMA(1, 0, At, B0); PG8_MMA(1, 1, At, B1); PG8_BAR; PG8_SCHED;
            } else {
            PG8_LDB(B0, 0, 0); PG8_SCHED; PG8_LDA(At, 0, 0); PG8_STAGE(PG8_SA(1, 1), a1 + hstep, voffA);
            PG8_WAIT_L(8); PG8_BAR; PG8_WAIT_L(0); PG8_MMA(0, 0, At, B0); PG8_BAR; PG8_SCHED;
            PG8_LDB(B1, 0, 1); PG8_STAGE(PG8_SB(0, 0), b2, voffB);
            PG8_BAR; PG8_WAIT_L(0); PG8_MMA(0, 1, At, B1); PG8_BAR;
            PG8_LDA(At, 0, 1); PG8_STAGE(PG8_SA(0, 0), a2, voffA);
            PG8_BAR; PG8_WAIT_L(0); PG8_MMA(1, 0, At, B0); PG8_BAR; PG8_SCHED;
            PG8_STAGE(PG8_SB(0, 1), b2 + hstep, voffB);
            PG8_WAIT_V(6); PG8_BAR; PG8_MMA(1, 1, At, B1); PG8_BAR;
            PG8_LDB(B0, 1, 0); PG8_SCHED; PG8_LDA(At, 1, 0); PG8_STAGE(PG8_SA(0, 1), a2 + hstep, voffA);
            PG8_WAIT_L(8); PG8_BAR; PG8_WAIT_L(0); PG8_MMA(0, 0, At, B0); PG8_BAR; PG8_SCHED;
            PG8_LDB(B1, 1, 1); PG8_STAGE(PG8_SB(1, 0), b3, voffB);
            PG8_BAR; PG8_WAIT_L(0); PG8_MMA(0, 1, At, B1); PG8_BAR;
            PG8_LDA(At, 1, 1); PG8_STAGE(PG8_SA(1, 0), a3, voffA);
            PG8_BAR; PG8_WAIT_L(0); PG8_MMA(1, 0, At, B0); PG8_BAR; PG8_SCHED;
            PG8_STAGE(PG8_SB(1, 1), b3 + hstep, voffB);
            PG8_WAIT_V(6); PG8_BAR; PG8_MMA(1, 1, At, B1); PG8_BAR;
            }
        }
        if constexpr (ALIGN_EPI) { if (wr == 0) PG8_BAR; }
        if constexpr (!Epi::AFTER_DRAIN) { E(acc, cur, wr, wc, fr, fq); S.done(cur); }
        if (!has_next) break;
#pragma unroll
        for (int a = 0; a < 2; ++a)
#pragma unroll
            for (int b = 0; b < 2; ++b)
#pragma unroll
                for (int m = 0; m < 4; ++m)
#pragma unroll
                    for (int n = 0; n < 2; ++n) acc[a][b][m][n] = (f32x4){0.f, 0.f, 0.f, 0.f};
        cur = nxt; cA = nA; cB = nB; ++ui;
        if constexpr (ALIGN_EPI) { if (wr == 1) PG8_BAR; }
    }
    PG8_WAIT_V(0);
    if constexpr (!ALIGN_EPI) { if (wr == 0) PG8_BAR; }
    PG8_BAR;
    if constexpr (Epi::AFTER_DRAIN) { E.fused(acc, cur, wr, wc, fr, fq, lds, wid, lane); S.done(cur); }
#undef PG8_SA
#undef PG8_SB
#undef PG8_STAGE
#undef PG8_LDA
#undef PG8_LDB
#undef PG8_MMA
#undef PG8_WAIT_V
#undef PG8_WAIT_L
#undef PG8_BAR
#undef PG8_SCHED
}
}
namespace pg8 {
struct EpiF32 {
    static constexpr bool PERM = false, AFTER_DRAIN = false;
    float* C; int ldc; const float* bias;
    __device__ __forceinline__ void operator()(const f32x4 (&acc)[2][2][4][2], const Unit& u, int wr, int wc, int fr, int fq) const {
        const int row0 = u.pm * BM + wr * 64 + fr, col0 = u.pn * BM + wc * 32 + 4 * fq;
        f32x4 bv[2][2];
#pragma unroll
        for (int bj = 0; bj < 2; ++bj)
#pragma unroll
            for (int n = 0; n < 2; ++n) bv[bj][n] = bias ? *(const f32x4*)(bias + col0 + bj * HALF + n * 16) : (f32x4){0.f, 0.f, 0.f, 0.f};
#pragma unroll
        for (int ai = 0; ai < 2; ++ai)
#pragma unroll
            for (int m = 0; m < 4; ++m) { float* rowp = C + (size_t)(row0 + ai * HALF + m * 16) * ldc + col0;
#pragma unroll
                for (int bj = 0; bj < 2; ++bj)
#pragma unroll
                    for (int n = 0; n < 2; ++n) *(f32x4*)(rowp + bj * HALF + n * 16) = acc[ai][bj][m][n] + bv[bj][n]; }
    }
};
}
#ifndef PG8_SP2
#define PG8_SP2 true
#endif
#ifndef PG8_ALIGN
#define PG8_ALIGN true
#endif
namespace pg8 {
struct EpiProj {
    static constexpr bool PERM = false, AFTER_DRAIN = false;
    float* U; bf16_t* QB; bf16_t* KB; bf16_t* VB; float* kout; float* vout; float* KSUM; const float* ROPE; float qscale;
    typedef unsigned u32x2v __attribute__((ext_vector_type(2)));
    template <bool ISV> __device__ __forceinline__ void plain(const f32x4 (&acc)[2][2][4][2], int row0, int cb, int wc, int fq) const {
#pragma unroll
        for (int ai = 0; ai < 2; ++ai)
#pragma unroll
            for (int m = 0; m < 4; ++m) { const size_t ro = (size_t)(row0 + ai * HALF + m * 16) * 512 + cb + wc * 32 + 4 * fq;
#pragma unroll
                for (int bj = 0; bj < 2; ++bj)
#pragma unroll
                    for (int n = 0; n < 2; ++n) { const f32x4 v = acc[ai][bj][m][n]; const size_t o = ro + bj * HALF + n * 16;
                        if (!ISV) *(f32x4*)(U + o) = v;
                        else { *(f32x4*)(vout + o) = v; u32x2v w; w.x = cvt_pk_bf16(v[0], v[1]); w.y = cvt_pk_bf16(v[2], v[3]); *(u32x2v*)(VB + o) = w; } } }
    }
    template <bool ISK> __device__ __forceinline__ void rope(const f32x4 (&acc)[2][2][4][2], const Unit& u, int row0, int cb, int wr, int wc, int fr, int fq) const {
        f32x4 s1[2], s2[2];
#pragma unroll
        for (int n = 0; n < 2; ++n) { s1[n] = (f32x4){0.f, 0.f, 0.f, 0.f}; s2[n] = (f32x4){0.f, 0.f, 0.f, 0.f}; }
#pragma unroll
        for (int ai = 0; ai < 2; ++ai)
#pragma unroll
            for (int m = 0; m < 4; ++m) { const int row = row0 + ai * HALF + m * 16, t = row & 8191;
#pragma unroll
                for (int n = 0; n < 2; ++n) { const int i0 = 16 * n + 4 * fq; const size_t o1 = (size_t)row * 512 + cb + wc * 64 + i0, o2 = o1 + 32;
                    const f32x4 cs0 = *(const f32x4*)(ROPE + (size_t)(t * 32 + i0) * 2), cs1 = *(const f32x4*)(ROPE + (size_t)(t * 32 + i0) * 2 + 4);
                    const f32x4 c = (f32x4){cs0[0], cs0[2], cs1[0], cs1[2]}, s = (f32x4){cs0[1], cs0[3], cs1[1], cs1[3]};
                    const f32x4 x1 = acc[ai][0][m][n], x2 = acc[ai][1][m][n];
                    const f32x4 y1 = x1 * c - x2 * s, y2 = x2 * c + x1 * s;
                    if (!ISK) { const f32x4 z1 = y1 * qscale, z2 = y2 * qscale; u32x2v w; w.x = cvt_pk_bf16(z1[0], z1[1]); w.y = cvt_pk_bf16(z1[2], z1[3]); *(u32x2v*)(QB + o1) = w;
                        w.x = cvt_pk_bf16(z2[0], z2[1]); w.y = cvt_pk_bf16(z2[2], z2[3]); *(u32x2v*)(QB + o2) = w; }
                    else { *(f32x4*)(kout + o1) = y1; *(f32x4*)(kout + o2) = y2; u32x2v w; w.x = cvt_pk_bf16(y1[0], y1[1]); w.y = cvt_pk_bf16(y1[2], y1[3]); *(u32x2v*)(KB + o1) = w;
                        w.x = cvt_pk_bf16(y2[0], y2[1]); w.y = cvt_pk_bf16(y2[2], y2[3]); *(u32x2v*)(KB + o2) = w; s1[n] += y1; s2[n] += y2; } }
                asm volatile("" ::: "memory"); }
        if (ISK) {
#pragma unroll
            for (int n = 0; n < 2; ++n) {
#pragma unroll
                for (int e = 0; e < 4; ++e) { float a = s1[n][e], b = s2[n][e];
#pragma unroll
                    for (int o = 1; o < 16; o <<= 1) { a += __shfl_xor(a, o); b += __shfl_xor(b, o); }
                    s1[n][e] = a; s2[n][e] = b; }
                if (fr == 0) { float* kp = KSUM + (size_t)(u.pm * 2 + wr) * 512 + cb + wc * 64 + 16 * n + 4 * fq; *(f32x4*)kp = s1[n]; *(f32x4*)(kp + 32) = s2[n]; } }
        }
    }
    __device__ __forceinline__ void operator()(const f32x4 (&acc)[2][2][4][2], const Unit& u, int wr, int wc, int fr, int fq) const {
        asm volatile("" : "+v"(fr), "+v"(fq));
        const int sec = u.pn >> 1, cb = (u.pn & 1) * 256, row0 = u.pm * BM + wr * 64 + fr;
        if (sec == 0) plain<false>(acc, row0, cb, wc, fq);
        else if (sec == 3) plain<true>(acc, row0, cb, wc, fq);
        else if (sec == 1) rope<false>(acc, u, row0, cb, wr, wc, fr, fq);
        else rope<true>(acc, u, row0, cb, wr, wc, fr, fq);
    }
};
}
#define GAS __attribute__((address_space(1)))
#define LAS __attribute__((address_space(3)))
typedef unsigned short bf16;
typedef unsigned v4u __attribute__((ext_vector_type(4)));
typedef float f32x4 __attribute__((ext_vector_type(4)));
typedef short bf16x8 __attribute__((ext_vector_type(8)));
typedef GAS unsigned gu32;
typedef GAS unsigned long long gu64;
#define RLX_AGENT __ATOMIC_RELAXED, __HIP_MEMORY_SCOPE_AGENT
#define LDS_WAIT() asm volatile("s_waitcnt lgkmcnt(0)" ::: "memory")
#define VM_WAIT() asm volatile("s_waitcnt vmcnt(0)" ::: "memory")
__device__ __forceinline__ unsigned long long rt() { return __builtin_amdgcn_s_memrealtime(); }
__device__ __forceinline__ unsigned f2bf(float f) { unsigned u = __builtin_bit_cast(unsigned, f); return (u + 0x7fffu + ((u >> 16) & 1u)) >> 16; }
__device__ __forceinline__ unsigned pk2(float lo, float hi) { return f2bf(lo) | (f2bf(hi) << 16); }

#define XB_TMO      128
#define XB_XCNT(j)  (256  + 64 * (j))
#define XB_XSUB(j)  (1280 + 64 * (j))
#define XB_XGEN(j)  (2304 + 64 * (j))
#define XB_TOP      3328
#define XB_TOPGEN   3392
#define XCD_BAR_WORDS 3456
#define XB_SPIN_CAP (1u << 18)

__device__ __forceinline__ unsigned xb_ld(unsigned* p)              { return __hip_atomic_load(p, __ATOMIC_RELAXED, __HIP_MEMORY_SCOPE_AGENT); }
__device__ __forceinline__ unsigned xb_add(unsigned* p, unsigned v) { return __hip_atomic_fetch_add(p, v, __ATOMIC_RELAXED, __HIP_MEMORY_SCOPE_AGENT); }
__device__ __forceinline__ unsigned xb_xcc_id() { return (unsigned)__builtin_amdgcn_s_getreg((3 << 11) | 20) & 0xFu; }
#define XB_SPIN(cond, bar) do { unsigned _sp = 0; while (cond) { __builtin_amdgcn_s_sleep(1); \
    if ((++_sp & 255u) == 0u) { if (xb_ld(&(bar)[XB_TMO])) break; if (_sp > XB_SPIN_CAP) { atomicAdd(&(bar)[XB_TMO], 1u); break; } } } } while (0)

struct XcdBarrier {
    unsigned* bar; unsigned x;
    volatile LAS unsigned* st;
};

__device__ __forceinline__ XcdBarrier xcd_barrier_post(unsigned* bar, volatile LAS unsigned* st) {
    XcdBarrier b; b.bar = bar; b.x = xb_xcc_id(); b.st = st;
    if (threadIdx.x == 0) (void)xb_add(&bar[XB_XCNT(b.x)], 1u);
    return b;
}
__device__ __forceinline__ void xcd_barrier_complete(unsigned* bar, unsigned x, unsigned& nloc, unsigned& nx) {
    const unsigned G = gridDim.x * gridDim.y * gridDim.z;
    unsigned sum, cnt, mine, sp = 0u;
    for (;;) {
        sum = 0u; cnt = 0u; mine = 0u;
#pragma unroll
        for (unsigned j = 0; j < 16; ++j) { const unsigned c = xb_ld(&bar[XB_XCNT(j)]); sum += c; cnt += (c > 0u) ? 1u : 0u; mine = (j == x) ? c : mine; }
        if (sum == G) break;
        __builtin_amdgcn_s_sleep(1);
        if ((++sp & 255u) == 0u) { if (xb_ld(&bar[XB_TMO])) break; if (sp > XB_SPIN_CAP) { atomicAdd(&bar[XB_TMO], 1u); break; } }
    }
    nloc = mine > 0u ? mine : 1u; nx = cnt > 0u ? cnt : 1u;
}

__device__ __forceinline__ void xcd_barrier(const XcdBarrier& b) {
    asm volatile("s_waitcnt vmcnt(0)" ::: "memory");
    __syncthreads();
    if (threadIdx.x == 0) {
        unsigned* bar = b.bar;
        __builtin_amdgcn_s_waitcnt(0);
        unsigned nloc = b.st[0], nx = b.st[1];
        if (nloc == 0u) { xcd_barrier_complete(bar, b.x, nloc, nx); b.st[0] = nloc; b.st[1] = nx; }
        const unsigned old = xb_add(&bar[XB_XSUB(b.x)], 1u);
        const unsigned gen = old / nloc;
        if (old + 1u == (gen + 1u) * nloc) {
            __builtin_amdgcn_fence(__ATOMIC_RELEASE, "agent");
            asm volatile("s_waitcnt vmcnt(0)" ::: "memory");
            const unsigned og = xb_add(&bar[XB_TOP], 1u);
            const unsigned tg = og / nx;
            if (og + 1u == (tg + 1u) * nx) xb_add(&bar[XB_TOPGEN], 1u);
            else XB_SPIN(xb_ld(&bar[XB_TOPGEN]) == tg, bar);
            __builtin_amdgcn_fence(__ATOMIC_ACQUIRE, "agent");
            xb_add(&bar[XB_XGEN(b.x)], 1u);
            asm volatile("s_waitcnt vmcnt(0)" ::: "memory");
        } else {
            XB_SPIN(xb_ld(&bar[XB_XGEN(b.x)]) == gen, bar);
            __builtin_amdgcn_fence(__ATOMIC_ACQUIRE, "agent");
            asm volatile("s_waitcnt vmcnt(0)" ::: "memory");
        }
    }
    __syncthreads();
}

namespace mb {
typedef short bf16x8 __attribute__((ext_vector_type(8)));
typedef short s16x4 __attribute__((ext_vector_type(4)));
typedef float f32x16 __attribute__((ext_vector_type(16)));
typedef unsigned u32x4 __attribute__((ext_vector_type(4)));
typedef __attribute__((address_space(3))) const char* lds_cptr;
constexpr float C2 = 0.125f * 1.4426950408889634f;
constexpr int PITCH = 512;
constexpr int L_K = 0, L_V = 32768, L_STG = 65536, STG_W = 8704  , L_MISC = 135168;
constexpr int M_WSF = 0, M_PRE = 2048, M_ROW = 4608, M_SCAL = 4864;
__device__ __forceinline__ int crow(int r, int hi) { return (r & 3) + 8 * (r >> 2) + 4 * hi; }
__device__ __forceinline__ void glds16(const void* gsrc, unsigned lds_dst) { unsigned keep;
    asm volatile("s_mov_b32 %0, m0\n\ts_mov_b32 m0, %2\n\ts_nop 0\n\tglobal_load_lds_dwordx4 %1, off\n\ts_mov_b32 m0, %0" : "=&s"(keep) : "v"(gsrc), "s"(lds_dst) : "memory"); }
typedef float f32x2_t __attribute__((ext_vector_type(2))); typedef __bf16 bf16x2_t __attribute__((ext_vector_type(2)));
__device__ __forceinline__ unsigned cvtpk_s(float lo, float hi) { f32x2_t v = {lo, hi}; bf16x2_t b = __builtin_convertvector(v, bf16x2_t); return __builtin_bit_cast(unsigned, b); }

__device__ __forceinline__ void stage_kv(const bf16* KB, const bf16* VB, size_t krow0, int hcol, unsigned lds0, int wid, int lane) {
    const bf16* ksrc = KB + (krow0 + lane) * PITCH + hcol + wid * 8;
    const bf16* vsrc = VB + (krow0 + 16 * (wid & 3) + (lane >> 2)) * PITCH + hcol + (wid >> 2) * 32 + (lane & 3) * 8;
#pragma unroll
    for (int j = 0; j < 4; ++j) {
        glds16(ksrc + (size_t)j * 64 * PITCH, (unsigned)__builtin_amdgcn_readfirstlane(lds0 + L_K + j * 8192 + wid * 1024));
        glds16(vsrc + (size_t)j * 64 * PITCH, (unsigned)__builtin_amdgcn_readfirstlane(lds0 + L_V + j * 8192 + wid * 1024));
    }
}
__device__ __forceinline__ void qkt(f32x16& p0, f32x16& p1, lds_cptr Kslot, const bf16x8 (&qr)[4], int r32, int hi) {
    const lds_cptr kb = Kslot + hi * 1024 + r32 * 16;
    const f32x16 z = {};
#pragma unroll
    for (int d0 = 0; d0 < 4; ++d0) {
        const bf16x8 b0 = *(const __attribute__((address_space(3))) bf16x8*)(kb + d0 * 2048);
        const bf16x8 b1 = *(const __attribute__((address_space(3))) bf16x8*)(kb + d0 * 2048 + 512);
        if (d0 == 0) { p0 = __builtin_amdgcn_mfma_f32_32x32x16_bf16(b0, qr[0], z, 0, 0, 0); p1 = __builtin_amdgcn_mfma_f32_32x32x16_bf16(b1, qr[0], z, 0, 0, 0); }
        else { p0 = __builtin_amdgcn_mfma_f32_32x32x16_bf16(b0, qr[d0], p0, 0, 0, 0); p1 = __builtin_amdgcn_mfma_f32_32x32x16_bf16(b1, qr[d0], p1, 0, 0, 0); }
    }
}
__device__ __forceinline__ void pv(f32x16 (&o)[2], int vb, bf16x8 pa0, bf16x8 pa1, bf16x8 pa2, bf16x8 pa3) {
#pragma unroll
    for (int d0 = 0; d0 < 2; ++d0) { s16x4 lo[4], hi[4];
#pragma unroll
        for (int ks = 0; ks < 4; ++ks) {
            asm volatile("ds_read_b64_tr_b16 %0,%1 offset:%c2" : "=&v"(lo[ks]) : "v"(vb), "i"(d0 * 4096 + ks * 1024) : "memory");
            asm volatile("ds_read_b64_tr_b16 %0,%1 offset:%c2" : "=&v"(hi[ks]) : "v"(vb), "i"(d0 * 4096 + ks * 1024 + 512) : "memory"); }
        asm volatile("s_waitcnt lgkmcnt(0)" ::: "memory"); __builtin_amdgcn_sched_barrier(0);
#define MB_PK(k) (bf16x8){lo[k][0], lo[k][1], lo[k][2], lo[k][3], hi[k][0], hi[k][1], hi[k][2], hi[k][3]}
        o[d0] = __builtin_amdgcn_mfma_f32_32x32x16_bf16(pa0, MB_PK(0), o[d0], 0, 0, 0);
        o[d0] = __builtin_amdgcn_mfma_f32_32x32x16_bf16(pa1, MB_PK(1), o[d0], 0, 0, 0);
        o[d0] = __builtin_amdgcn_mfma_f32_32x32x16_bf16(pa2, MB_PK(2), o[d0], 0, 0, 0);
        o[d0] = __builtin_amdgcn_mfma_f32_32x32x16_bf16(pa3, MB_PK(3), o[d0], 0, 0, 0);
#undef MB_PK
    }
}
template <bool CAUSAL> __device__ __forceinline__ void attend256(const bf16x8 (&qr)[4], lds_cptr lds, unsigned lds0, int lane, int qloc, int jmax, float& m_out, float& l_out, f32x16 (&o)[2]) {
    const int r32 = lane & 31, hi = lane >> 5;
    f32x16 p0[4], p1[4];
#pragma unroll
    for (int j = 0; j < 4; ++j) {
        if (!CAUSAL || j <= jmax) {
            qkt(p0[j], p1[j], lds + L_K + j * 8192, qr, r32, hi);
            if (CAUSAL) {
#pragma unroll
                for (int r = 0; r < 16; ++r) { const int kv = 64 * j + crow(r, hi); if (kv > qloc) p0[j][r] = -INFINITY; if (kv + 32 > qloc) p1[j][r] = -INFINITY; }
            }
        } else {
#pragma unroll
            for (int r = 0; r < 16; ++r) { p0[j][r] = -INFINITY; p1[j][r] = -INFINITY; }
        }
    }
    float mx = -INFINITY;
#pragma unroll
    for (int j = 0; j < 4; ++j)
#pragma unroll
        for (int r = 0; r < 16; ++r) mx = fmaxf(mx, fmaxf(p0[j][r], p1[j][r]));
    mx = fmaxf(mx, __shfl_xor(mx, 32));
    float ls = 0.f;
    __builtin_amdgcn_sched_barrier(0);
    u32x4 pw[4][4];
#pragma unroll
    for (int j = 0; j < 4; ++j) {
        if (!CAUSAL || j <= jmax) {
#pragma unroll
            for (int r = 0; r < 16; ++r) { p0[j][r] = __builtin_amdgcn_exp2f(p0[j][r] - mx); p1[j][r] = __builtin_amdgcn_exp2f(p1[j][r] - mx); ls += p0[j][r] + p1[j][r]; }
            pw[j][0] = (u32x4){cvtpk_s(p0[j][0], p0[j][1]), cvtpk_s(p0[j][2], p0[j][3]), cvtpk_s(p0[j][4], p0[j][5]), cvtpk_s(p0[j][6], p0[j][7])};
            pw[j][1] = (u32x4){cvtpk_s(p0[j][8], p0[j][9]), cvtpk_s(p0[j][10], p0[j][11]), cvtpk_s(p0[j][12], p0[j][13]), cvtpk_s(p0[j][14], p0[j][15])};
            pw[j][2] = (u32x4){cvtpk_s(p1[j][0], p1[j][1]), cvtpk_s(p1[j][2], p1[j][3]), cvtpk_s(p1[j][4], p1[j][5]), cvtpk_s(p1[j][6], p1[j][7])};
            pw[j][3] = (u32x4){cvtpk_s(p1[j][8], p1[j][9]), cvtpk_s(p1[j][10], p1[j][11]), cvtpk_s(p1[j][12], p1[j][13]), cvtpk_s(p1[j][14], p1[j][15])};
        } else {
#pragma unroll
            for (int k = 0; k < 4; ++k) pw[j][k] = (u32x4){0u, 0u, 0u, 0u};
        }
    }
    __builtin_amdgcn_sched_barrier(0);
    o[0] = f32x16{}; o[1] = f32x16{};
    const int vb0 = (int)(lds0 + L_V) + ((lane >> 4) & 1) * 32 + (lane & 3) * 8 + (4 * hi + ((lane & 15) >> 2)) * 64;
#pragma unroll
    for (int j = 0; j < 4; ++j) {
        if (!CAUSAL || j <= jmax)
            pv(o, vb0 + j * 8192, __builtin_bit_cast(bf16x8, pw[j][0]), __builtin_bit_cast(bf16x8, pw[j][1]), __builtin_bit_cast(bf16x8, pw[j][2]), __builtin_bit_cast(bf16x8, pw[j][3]));
    }
    ls += __shfl_xor(ls, 32);
    m_out = mx; l_out = ls;
}
__device__ __forceinline__ void stage_o(const f32x16 (&o)[2], __attribute__((address_space(3))) float* stg, int lane) {
    const int r32 = lane & 31, hi = lane >> 5;
#pragma unroll
    for (int d0 = 0; d0 < 2; ++d0)
#pragma unroll
        for (int r = 0; r < 16; ++r) stg[crow(r, hi) * 68 + d0 * 32 + r32] = o[d0][r];
}
}

constexpr int D = 1024, NB = 2, T = 8192, MP = NB * T, DB = 128, MR = MP + DB  , MT = 16640  ;
constexpr int NH = 8, HD = 64, AW = 512, PW = 512, INW = 2048, FF = 2816, FF2 = 5632;
constexpr int NPAGES = 16, PSTATE = 15, NBLK_P = 32, NBLK_D = 8;
constexpr float RMS_EPS = 1e-6f;
constexpr int NWAVES = 8, NTHREADS = 512;

constexpr size_t O_YP = 0, O_YS = O_YP + (size_t)MP * D, O_KP = O_YS + (size_t)DB * D, O_VP = O_KP + (size_t)MP * AW, O_PP = O_VP + (size_t)MP * AW,
                 O_CP = O_PP + (size_t)NB * PSTATE * PW, O_KS = O_CP + (size_t)NB * 2 * FF2, O_VS = O_KS + (size_t)DB * AW, O_PS = O_VS + (size_t)DB * AW,
                 O_CS = O_PS + (size_t)DB * PSTATE * PW, O_END = O_CS + (size_t)DB * 2 * FF2;
static_assert(O_END == 36279296, "output size");

constexpr size_t MiB = 1u << 20;
constexpr size_t WS_CTL = 0, CTL_ZERO_BYTES = 1 * MiB;
constexpr size_t WS_WIN = 2 * MiB, WS_WO2 = 6 * MiB, WS_WUP = 8 * MiB, WS_WDN = 19 * MiB, WS_MOD = 25 * MiB, WS_ROPE = 29 * MiB, WS_KMD = 31 * MiB, WS_KMP = 33 * MiB;
constexpr size_t WS_XN = 34 * MiB, WS_PROJ = 67 * MiB, WS_QF = 197 * MiB, WS_A2 = 230 * MiB, WS_MIX = 263 * MiB, WS_X1 = 328 * MiB, WS_UP = 393 * MiB, WS_ACT = 751 * MiB, WS_FFN = 841 * MiB, WS_QB = 906 * MiB, WS_KB = 923 * MiB, WS_VB = 940 * MiB, WS_LIST = 957 * MiB, WS_COUNT = 965 * MiB, WS_PO = 966 * MiB, WS_PM = 1016 * MiB, WS_A2REF = 1020 * MiB, WS_U = 1037 * MiB, WS_KSUM = 1070 * MiB, WS_DPO = 1071 * MiB, WS_DPM = 1073 * MiB, WS_END = 1074 * MiB;
static_assert(WS_WIN + (size_t)INW * D * 2 <= WS_WO2 && WS_WO2 + (size_t)D * D * 2 <= WS_WUP && WS_WUP + (size_t)FF2 * D * 2 <= WS_WDN && WS_WDN + (size_t)D * FF * 2 <= WS_MOD, "ws map 1");
static_assert(WS_MOD + (size_t)130 * 6 * D * 4 <= WS_ROPE && WS_ROPE + (size_t)T * 32 * 8 <= WS_KMD && WS_KMD + (size_t)DB * NBLK_D * AW * 4 <= WS_KMP && WS_KMP + (size_t)NB * NBLK_P * AW * 4 <= WS_XN, "ws map 2");
static_assert(WS_XN + (size_t)MT * D * 2 <= WS_PROJ && WS_PROJ + (size_t)MT * INW * 4 <= WS_QF && WS_QF + (size_t)MT * AW * 4 <= WS_A2 && WS_A2 + (size_t)MT * D * 2 <= WS_MIX, "ws map 3");
static_assert(WS_QB + (size_t)MT * AW * 2 <= WS_KB && WS_KB + (size_t)MT * AW * 2 <= WS_VB && WS_VB + (size_t)MT * AW * 2 <= WS_LIST && WS_LIST + (size_t)16 * 32 * 32 * 256 * 2 <= WS_COUNT && WS_COUNT + 16 * 32 * 32 * 4 <= WS_PO && WS_PO + (size_t)MP * NH * 3 * 64 * 2 <= WS_PM && WS_PM + (size_t)MP * NH * 3 * 8 <= WS_A2REF && WS_A2REF + (size_t)MP * AW * 2 <= WS_END, "ws map 5");
static_assert(WS_U + (size_t)MP * PW * 4 <= WS_KSUM && WS_KSUM + (size_t)64 * 2 * 512 * 4 <= WS_DPO && WS_DPO + (size_t)DB * NH * 6 * HD * 4 <= WS_DPM && WS_DPM + (size_t)DB * NH * 6 * 8 <= WS_END, "ws map 6");
static_assert(WS_MIX + (size_t)MT * D * 4 <= WS_X1 && WS_X1 + (size_t)MT * D * 4 <= WS_UP && WS_UP + (size_t)MT * FF2 * 4 <= WS_ACT && WS_ACT + (size_t)MT * FF * 2 <= WS_FFN && WS_FFN + (size_t)MT * D * 4 <= WS_END, "ws map 4");
constexpr int CW_BAR = 4096;

constexpr int LDS_BYTES = 147456;
constexpr int LDSCTL_OFF = 146432, MISC_OFF = LDSCTL_OFF;

__device__ const double ROPE_INV[32] = {
1.00000000000000000000e+00, 7.49894209332455874417e-01, 5.62341325190349072827e-01, 4.21696503428582225581e-01, 3.16227766016837941176e-01, 2.37137370566165517349e-01, 1.77827941003892292526e-01, 1.33352143216332402753e-01,
1.00000000000000005551e-01, 7.49894209332455791150e-02, 5.62341325190349114460e-02, 4.21696503428582239459e-02, 3.16227766016837913421e-02, 2.37137370566165538166e-02, 1.77827941003892292526e-02, 1.33352143216332406223e-02,
1.00000000000000002082e-02, 7.49894209332455791150e-03, 5.62341325190349097113e-03, 4.21696503428582291501e-03, 3.16227766016837939442e-03, 2.37137370566165538166e-03, 1.77827941003892275179e-03, 1.33352143216332406223e-03,
1.00000000000000002082e-03, 7.49894209332455856203e-04, 5.62341325190349097113e-04, 4.21696503428582237290e-04, 3.16227766016837939442e-04, 2.37137370566165538166e-04, 1.77827941003892269758e-04, 1.33352143216332395381e-04};

struct Args { const void* in[23]; float* out; unsigned char* ws; int ph_lo, ph_hi; };

struct Ctx {
    LAS unsigned char* lds;
    int tid, lane, wave, gw, NGW, G;
    const float *x_prompt, *x_sample, *c_prompt, *c_sample, *cache_k, *cache_v; const int* page_table; const float *state_pool, *state_conv;
    const float *w_ada, *b_ada, *g_mix_pre, *g_mix_post, *w_in, *pool_w, *pool_scale, *w_out, *g_ffn_pre, *g_ffn_post, *w_up, *conv_w, *conv_b, *w_down;
    float* out;
    bf16 *WIN, *WO2, *WUP, *WDN, *XN, *A2, *ACT, *QB, *KB, *VB, *PO, *A2REF; unsigned short* LIST; int* COUNT; float2* PM; unsigned* ctl; float *U, *KSUM, *DPO; float2* DPM; float *MOD, *KMD, *KMP, *PROJ, *QF, *MIX, *X1, *UP, *FFN; float2* ROPE;
};

__device__ __forceinline__ float wave_sum(float v) {
#pragma unroll
    for (int o = 1; o < 64; o <<= 1) v += __shfl_xor(v, o);
    return v;
}
__device__ __forceinline__ float wave_max(float v) {
#pragma unroll
    for (int o = 1; o < 64; o <<= 1) v = fmaxf(v, __shfl_xor(v, o));
    return v;
}
__device__ __forceinline__ float silu_f(float v) { return v / (1.0f + __expf(-v)); }

__device__ __forceinline__ void dsincos(double a, double& s, double& c) {
    const double k = __builtin_rint(a * 0.63661977236758134308);
    double r = __builtin_fma(-k, 1.57079632679489655800e+00, a);
    r = __builtin_fma(-k, 6.12323399573676603587e-17, r);
    const double r2 = r * r;
    double sp = 1.0 / 6227020800.0;
    sp = sp * r2 - 1.0 / 39916800.0; sp = sp * r2 + 1.0 / 362880.0; sp = sp * r2 - 1.0 / 5040.0; sp = sp * r2 + 1.0 / 120.0; sp = sp * r2 - 1.0 / 6.0;
    const double sn = r + r * r2 * sp;
    double cp = -1.0 / 87178291200.0;
    cp = cp * r2 + 1.0 / 479001600.0; cp = cp * r2 - 1.0 / 3628800.0; cp = cp * r2 + 1.0 / 40320.0; cp = cp * r2 - 1.0 / 720.0; cp = cp * r2 + 1.0 / 24.0; cp = cp * r2 - 0.5;
    const double cn = 1.0 + r2 * cp;
    const int q = ((int)k) & 3;
    s = (q == 0) ? sn : (q == 1) ? cn : (q == 2) ? -sn : -cn;
    c = (q == 0) ? cn : (q == 1) ? -sn : (q == 2) ? -cn : sn;
}

__device__ __forceinline__ void transpose_item(const float* W, int ldw, bf16* WT, int ldt, int koff, int nblk, LAS float* scr, int item, int lane, bool ropeperm = false) {
    const int kb = item / nblk, nb = item % nblk, k0 = 64 * kb, n0 = 32 * nb;
#pragma unroll 8
    for (int i = 0; i < 32; ++i) { const int kk = 2 * i + (lane >> 5); scr[kk * 33 + (lane & 31)] = W[(size_t)(k0 + kk) * ldw + n0 + (lane & 31)]; }
    LDS_WAIT(); asm volatile("" ::: "memory");
    const int c = lane & 7;
#pragma unroll
    for (int j = 0; j < 4; ++j) { const int n = (lane >> 3) + 8 * j; const LAS float* s = scr + (8 * c) * 33 + n;
        v4u o; o.x = pk2(s[0 * 33], s[1 * 33]); o.y = pk2(s[2 * 33], s[3 * 33]); o.z = pk2(s[4 * 33], s[5 * 33]); o.w = pk2(s[6 * 33], s[7 * 33]);
        int dn = n0 + n;
        if (ropeperm && dn >= 512 && dn < 1536) { const int o_ = dn & 255, hh = o_ >> 6, jj = o_ & 63; dn = (dn & ~255) + ((jj < 32) ? hh * 32 + jj : 128 + hh * 32 + (jj - 32)); }
        *(GAS v4u*)(WT + (size_t)dn * ldt + koff + k0 + 8 * c) = o; }
    LDS_WAIT(); asm volatile("" ::: "memory");
}

__device__ __forceinline__ void p0_prologue(Ctx& F) {
    {
        LAS float* sl = (LAS float*)F.lds;
        for (int item = blockIdx.x; item < 120; item += F.G) {
            const int nch = item % 12, rg = item / 12;
            __syncthreads();
            for (int e = F.tid; e < 13 * D; e += NTHREADS) { const int rr = e >> 10, k = e & 1023, row = rg * 13 + rr;
                const float cv = (row < 2) ? F.c_prompt[row * D + k] : F.c_sample[(row - 2) * D + k]; sl[e] = silu_f(cv); }
            __syncthreads();
            const int n = nch * 512 + F.tid;
            float acc[13];
#pragma unroll
            for (int rr = 0; rr < 13; ++rr) acc[rr] = 0.f;
            for (int k = 0; k < D; ++k) { const float w = F.w_ada[(size_t)k * (6 * D) + n];
#pragma unroll
                for (int rr = 0; rr < 13; ++rr) acc[rr] += sl[rr * D + k] * w; }
            const float bv = F.b_ada[n];
#pragma unroll
            for (int rr = 0; rr < 13; ++rr) F.MOD[(size_t)(rg * 13 + rr) * (6 * D) + n] = acc[rr] + bv;
        }
        __syncthreads();
    }
    {
        LAS float* scr = (LAS float*)(F.lds + F.wave * 16384);
        constexpr int I_IN = (D / 64) * (INW / 32), I_O = (512 / 64) * (D / 32), I_UP = (D / 64) * (FF2 / 32), I_DN = (FF / 64) * (D / 32);
        constexpr int NITEMS = I_IN + I_O + I_UP + I_DN;
        for (int it = F.gw; it < NITEMS; it += F.NGW) {
            int r = it;
            if (r < I_IN) { transpose_item(F.w_in, INW, F.WIN, D, 0, INW / 32, scr, r, F.lane, true); continue; } r -= I_IN;
            if (r < I_O) { transpose_item(F.w_out + (size_t)512 * D, D, F.WO2, D, 512, D / 32, scr, r, F.lane); continue; } r -= I_O;
            if (r < I_UP) { transpose_item(F.w_up, FF2, F.WUP, D, 0, FF2 / 32, scr, r, F.lane); continue; } r -= I_UP;
            transpose_item(F.w_down, D, F.WDN, FF, 0, D / 32, scr, r, F.lane);
        }
    }
    for (int it = F.gw; it < D * 8; it += F.NGW) {
        const int n = it >> 3, kch = it & 7, k = kch * 64 + F.lane, g = k >> 7;
        const float* pw = F.pool_w + (size_t)k * 128;
        float acc = 0.f;
        for (int d = 0; d < 128; ++d) acc += pw[d] * (F.pool_scale[g * 128 + d] * F.w_out[(size_t)(g * 128 + d) * D + n]);
        F.WO2[(size_t)n * D + k] = (bf16)f2bf(acc);
    }
    for (int e = blockIdx.x * NTHREADS + F.tid; e < T * 32; e += F.G * NTHREADS) {
        const int pos = e >> 5, i = e & 31; double s, c; dsincos((double)pos * ROPE_INV[i], s, c);
        F.ROPE[e] = make_float2((float)c, (float)s);
    }
    {
        LAS f32x4* red = (LAS f32x4*)F.lds;
        const int ts = F.tid >> 7, c4 = F.tid & 127;
        for (int item = blockIdx.x; item < DB * NBLK_D; item += F.G) {
            const int b = item >> 3, n = item & 7;
            const int pg0 = F.page_table[b * NPAGES + 2 * n], pg1 = F.page_table[b * NPAGES + 2 * n + 1];
            f32x4 acc = (f32x4){0.f, 0.f, 0.f, 0.f};
#pragma unroll 8
            for (int itk = 0; itk < 64; ++itk) { const int tok = itk * 4 + ts; const int pg = (tok < 128) ? pg0 : pg1;
                acc += *(const f32x4*)(F.cache_k + ((size_t)pg * 128 + (tok & 127)) * AW + c4 * 4); }
            __syncthreads();
            red[ts * 128 + c4] = acc;
            __syncthreads();
            if (F.tid < 128) { const f32x4 s = (red[c4] + red[128 + c4]) + (red[256 + c4] + red[384 + c4]);
                *(f32x4*)(F.KMD + (size_t)item * AW + c4 * 4) = s * (1.0f / 256.0f); }
        }
        __syncthreads();
    }
}

__device__ __forceinline__ const float* x_row(const Ctx& F, int r) { return (r < MP) ? F.x_prompt + (size_t)r * D : F.x_sample + (size_t)(r - MP) * D; }
__device__ __forceinline__ int mod_row(int r) { return (r < MP) ? (r >> 13) : 2 + (r - MP); }

__device__ __forceinline__ void p1_norm_in(Ctx& F) {
    for (int r = F.gw; r < MT; r += F.NGW) {
        GAS unsigned long long* o8 = (GAS unsigned long long*)(F.XN + (size_t)r * D) + F.lane;
        if (r >= MR) {
#pragma unroll
            for (int j = 0; j < 4; ++j) o8[64 * j] = 0ull;
            GAS unsigned long long* a8 = (GAS unsigned long long*)(F.A2 + (size_t)r * D) + F.lane;
#pragma unroll
            for (int j = 0; j < 4; ++j) a8[64 * j] = 0ull;
            GAS unsigned long long* c8 = (GAS unsigned long long*)(F.ACT + (size_t)r * FF) + F.lane;
            for (int j = 0; j < FF / 256; ++j) c8[64 * j] = 0ull;
            continue;
        }
        const f32x4* xr = (const f32x4*)x_row(F, r) + F.lane;
        const float* mod = F.MOD + (size_t)mod_row(r) * (6 * D);
        f32x4 v[4]; float ss = 0.f;
#pragma unroll
        for (int j = 0; j < 4; ++j) { v[j] = xr[64 * j]; ss += (v[j].x * v[j].x + v[j].y * v[j].y) + (v[j].z * v[j].z + v[j].w * v[j].w); }
        const float rs = 1.0f / sqrtf(wave_sum(ss) * (1.0f / D) + RMS_EPS);
#pragma unroll
        for (int j = 0; j < 4; ++j) { const int c = 4 * F.lane + 256 * j;
            const f32x4 g = *(const f32x4*)(F.g_mix_pre + c), sh = *(const f32x4*)(mod + c), sc = *(const f32x4*)(mod + D + c);
            const f32x4 h = v[j] * rs * g * (sc + 1.0f) + sh;
            o8[64 * j] = (unsigned long long)pk2(h.x, h.y) | ((unsigned long long)pk2(h.z, h.w) << 32); }
    }
}

__device__ __forceinline__ void p3_post_proj(Ctx& F) {
    for (int r = MP + F.gw; r < MR; r += F.NGW) {
        const bool dec = r >= MP; const int bb = dec ? (r - MP) : (r >> 13), t = dec ? 0 : (r & (T - 1)), pos = dec ? 2048 : t;
        const float* P = F.PROJ + (size_t)r * INW;
        float* kout = dec ? F.out + O_KS + (size_t)bb * AW : F.out + O_KP + (size_t)r * AW;
        float* vout = dec ? F.out + O_VS + (size_t)bb * AW : F.out + O_VP + (size_t)r * AW;
        float* qout = F.QF + (size_t)r * AW;
#pragma unroll
        for (int j = 0; j < 4; ++j) { const int pi = F.lane + 64 * j, hh = pi >> 5, i = pi & 31, col = hh * 64 + i;
            const float2 cs = F.ROPE[pos * 32 + i];
            const int pcol = (hh >> 2) * 256 + (hh & 3) * 32 + i;
            const float q1 = P[512 + pcol], q2 = P[512 + pcol + 128], k1 = P[1024 + pcol], k2 = P[1024 + pcol + 128];
            const float qa = q1 * cs.x - q2 * cs.y, qb = q2 * cs.x + q1 * cs.y, ka = k1 * cs.x - k2 * cs.y, kb = k2 * cs.x + k1 * cs.y;
            qout[col] = qa; qout[col + 32] = qb; kout[col] = ka; kout[col + 32] = kb;
            F.QB[(size_t)r * AW + col] = (bf16)f2bf(qa * mb::C2); F.QB[(size_t)r * AW + col + 32] = (bf16)f2bf(qb * mb::C2);
            F.KB[(size_t)r * AW + col] = (bf16)f2bf(ka); F.KB[(size_t)r * AW + col + 32] = (bf16)f2bf(kb); }
#pragma unroll
        for (int j = 0; j < 2; ++j) { const f32x4 vv = *(const f32x4*)(P + 1536 + (F.lane + 64 * j) * 4); *(f32x4*)(vout + (F.lane + 64 * j) * 4) = vv;
            *(GAS unsigned long long*)(F.VB + (size_t)r * AW + (F.lane + 64 * j) * 4) = (unsigned long long)pk2(vv.x, vv.y) | ((unsigned long long)pk2(vv.z, vv.w) << 32); }
        const int c = F.lane * 8, g = c >> 7, w = 2 << g;
        const f32x4 u0 = *(const f32x4*)(P + c), u1 = *(const f32x4*)(P + c + 4);
        f32x4 s0 = u0, s1 = u1; int nterms;
        if (!dec) {
            nterms = (t + 1 < w) ? t + 1 : w;
            for (int s = 1; s < 16; ++s) if (s < nterms) { const float* pp = P - (size_t)s * INW + c; s0 += *(const f32x4*)pp; s1 += *(const f32x4*)(pp + 4); }
            if (t >= T - PSTATE) { float* po = F.out + O_PP + ((size_t)bb * PSTATE + (t - (T - PSTATE))) * PW + c; *(f32x4*)po = u0; *(f32x4*)(po + 4) = u1; }
        } else {
            nterms = w;
            const float* sp = F.state_pool + (size_t)bb * PSTATE * PW + c;
            for (int s = 1; s < 16; ++s) if (s < w) { const float* pp = sp + (size_t)(PSTATE - s) * PW; s0 += *(const f32x4*)pp; s1 += *(const f32x4*)(pp + 4); }
            float* po = F.out + O_PS + (size_t)bb * PSTATE * PW + c;
            for (int j = 0; j < PSTATE - 1; ++j) { *(f32x4*)(po + (size_t)j * PW) = *(const f32x4*)(sp + (size_t)(j + 1) * PW); *(f32x4*)(po + (size_t)j * PW + 4) = *(const f32x4*)(sp + (size_t)(j + 1) * PW + 4); }
            *(f32x4*)(po + (size_t)(PSTATE - 1) * PW) = u0; *(f32x4*)(po + (size_t)(PSTATE - 1) * PW + 4) = u1;
        }
        const float inv = 1.0f / (float)nterms;
        const f32x4 p0 = s0 * inv - u0, p1 = s1 * inv - u1;
        v4u o; o.x = pk2(p0.x, p0.y); o.y = pk2(p0.z, p0.w); o.z = pk2(p1.x, p1.y); o.w = pk2(p1.z, p1.w);
        *(GAS v4u*)(F.A2 + (size_t)r * D + c) = o;
    }
}


__device__ __forceinline__ void p3_pool_prompt(Ctx& F) {
    for (int r = F.gw; r < MP; r += F.NGW) {
        const int bb = r >> 13, t = r & (T - 1);
        const float* P = F.U + (size_t)r * PW;
        const int c = F.lane * 8, g = c >> 7, w = 2 << g;
        const f32x4 u0 = *(const f32x4*)(P + c), u1 = *(const f32x4*)(P + c + 4);
        f32x4 s0 = u0, s1 = u1;
        const int nterms = (t + 1 < w) ? t + 1 : w;
        for (int s = 1; s < 16; ++s) if (s < nterms) { const float* pp = P - (size_t)s * PW + c; s0 += *(const f32x4*)pp; s1 += *(const f32x4*)(pp + 4); }
        if (t >= T - PSTATE) { float* po = F.out + O_PP + ((size_t)bb * PSTATE + (t - (T - PSTATE))) * PW + c; *(f32x4*)po = u0; *(f32x4*)(po + 4) = u1; }
        const float inv = 1.0f / (float)nterms;
        const f32x4 p0 = s0 * inv - u0, p1 = s1 * inv - u1;
        v4u o; o.x = pk2(p0.x, p0.y); o.y = pk2(p0.z, p0.w); o.z = pk2(p1.x, p1.y); o.w = pk2(p1.z, p1.w);
        *(GAS v4u*)(F.A2 + (size_t)r * D + c) = o;
    }
}

template <bool PROMPT_REF> __device__ __forceinline__ void p4_attention_naive(Ctx& F) {
    LAS float* qs = (LAS float*)(F.lds + F.wave * 8192);
    LAS float* S = qs + 64;
    const float* Kf = F.out + O_KP; const float* Vf = F.out + O_VP;
    const int I0 = PROMPT_REF ? 0 : MP * NH, NITEM = PROMPT_REF ? MP * NH : MP * NH + DB * NH;
    for (int idx = I0 + F.gw; idx < NITEM; idx += F.NGW) {
        const bool dec = idx >= MP * NH;
        const int r = dec ? MP + ((idx - MP * NH) >> 3) : (idx >> 3), hh = idx & 7;
        const int bb = dec ? (r - MP) : (r >> 13), t = dec ? 2048 : (r & (T - 1)), own = t >> 8;
        LDS_WAIT(); asm volatile("" ::: "memory");
        qs[F.lane] = F.QF[(size_t)r * AW + hh * HD + F.lane];
        LDS_WAIT(); asm volatile("" ::: "memory");
        float gate = -INFINITY;
        if (F.lane < own) {
            const float* km = dec ? F.KMD + ((size_t)bb * NBLK_D + F.lane) * AW + hh * HD : F.KMP + ((size_t)bb * NBLK_P + F.lane) * AW + hh * HD;
            float acc = 0.f;
            for (int d = 0; d < HD; ++d) acc += qs[d] * km[d];
            gate = acc;
        }
        int sel0 = 0, sel1 = 0, sel2 = 0, nsel = 0;
#pragma unroll
        for (int k = 0; k < 3; ++k) {
            const float m = wave_max(gate);
            if (m != -INFINITY) {
                const unsigned long long bal = __ballot(gate == m);
                const int ix = __ffsll((long long)bal) - 1;
                if (k == 0) sel0 = ix; else if (k == 1) sel1 = ix; else sel2 = ix;
                nsel = k + 1;
                if (F.lane == ix) gate = -INFINITY;
            }
        }
        const int nblk = nsel + 1;
        float lmax = -INFINITY;
        for (int j = 0; j < nblk; ++j) {
            const int blk = (j < nsel) ? ((j == 0) ? sel0 : (j == 1) ? sel1 : sel2) : own;
            if (dec && j == nsel) {
                const float* kp = F.out + O_KS + (size_t)bb * AW + hh * HD;
                float acc = 0.f;
                for (int d = 0; d < HD; ++d) acc += qs[d] * kp[d];
                const float s = acc * 0.125f;
                if (F.lane == 0) S[j * 256] = s;
                lmax = fmaxf(lmax, s);
                continue;
            }
            for (int rr = 0; rr < 4; ++rr) {
                const int kk = rr * 64 + F.lane, key = blk * 256 + kk;
                const float* kp;
                if (dec) { const int pg = F.page_table[bb * NPAGES + 2 * blk + (kk >> 7)]; kp = F.cache_k + ((size_t)pg * 128 + (kk & 127)) * AW + hh * HD; }
                else kp = Kf + ((size_t)bb * T + key) * AW + hh * HD;
                float acc = 0.f;
#pragma unroll
                for (int d4 = 0; d4 < 16; ++d4) { const f32x4 kv = *(const f32x4*)(kp + 4 * d4); const f32x4 qv = *(const LAS f32x4*)(qs + 4 * d4);
                    acc += (kv.x * qv.x + kv.y * qv.y) + (kv.z * qv.z + kv.w * qv.w); }
                float s = acc * 0.125f;
                if (key > t) s = -INFINITY;
                S[j * 256 + kk] = s;
                lmax = fmaxf(lmax, s);
            }
        }
        const float m = wave_max(lmax);
        LDS_WAIT(); asm volatile("" ::: "memory");
        const int nkeys = (dec ? nsel * 256 + 1 : nblk * 256);
        float lsum = 0.f;
        for (int e = F.lane; e < nkeys; e += 64) { const float p = __expf(S[e] - m); S[e] = p; lsum += p; }
        const float l = wave_sum(lsum);
        LDS_WAIT(); asm volatile("" ::: "memory");
        float acc = 0.f;
        for (int j = 0; j < nblk; ++j) {
            const int blk = (j < nsel) ? ((j == 0) ? sel0 : (j == 1) ? sel1 : sel2) : own;
            if (dec && j == nsel) { acc += S[j * 256] * F.out[O_VS + (size_t)bb * AW + hh * HD + F.lane]; continue; }
            int kend = 256;
            if (!dec && j == nsel) kend = t - own * 256 + 1;
            if (dec) {
                const int pg0 = F.page_table[bb * NPAGES + 2 * blk], pg1 = F.page_table[bb * NPAGES + 2 * blk + 1];
                for (int kk = 0; kk < 256; ++kk) { const int pg = (kk < 128) ? pg0 : pg1;
                    acc += S[j * 256 + kk] * F.cache_v[((size_t)pg * 128 + (kk & 127)) * AW + hh * HD + F.lane]; }
            } else {
                const float* vp = Vf + ((size_t)bb * T + blk * 256) * AW + hh * HD + F.lane;
                for (int kk = 0; kk < kend; ++kk) acc += S[j * 256 + kk] * vp[(size_t)kk * AW];
            }
        }
        if (PROMPT_REF) F.A2REF[(size_t)r * AW + hh * HD + F.lane] = (bf16)f2bf(acc / l);
        else F.A2[(size_t)r * D + 512 + hh * HD + F.lane] = (bf16)f2bf(acc / l);
    }
}

__device__ __forceinline__ void p6_mid_norm(Ctx& F) {
    for (int r = F.gw; r < MR; r += F.NGW) {
        const f32x4* xr = (const f32x4*)x_row(F, r) + F.lane;
        const f32x4* mr = (const f32x4*)(F.MIX + (size_t)r * D) + F.lane;
        const float* mod = F.MOD + (size_t)mod_row(r) * (6 * D);
        f32x4 v[4]; float ss = 0.f;
#pragma unroll
        for (int j = 0; j < 4; ++j) { v[j] = mr[64 * j]; ss += (v[j].x * v[j].x + v[j].y * v[j].y) + (v[j].z * v[j].z + v[j].w * v[j].w); }
        const float rs = 1.0f / sqrtf(wave_sum(ss) * (1.0f / D) + RMS_EPS);
        float ss2 = 0.f;
#pragma unroll
        for (int j = 0; j < 4; ++j) { const int c = 4 * F.lane + 256 * j;
            const f32x4 g = *(const f32x4*)(F.g_mix_post + c), gt = *(const f32x4*)(mod + 2 * D + c);
            v[j] = xr[64 * j] + gt * (v[j] * rs * g);
            *((f32x4*)(F.X1 + (size_t)r * D) + F.lane + 64 * j) = v[j];
            ss2 += (v[j].x * v[j].x + v[j].y * v[j].y) + (v[j].z * v[j].z + v[j].w * v[j].w); }
        const float rs2 = 1.0f / sqrtf(wave_sum(ss2) * (1.0f / D) + RMS_EPS);
        GAS unsigned long long* o8 = (GAS unsigned long long*)(F.XN + (size_t)r * D) + F.lane;
#pragma unroll
        for (int j = 0; j < 4; ++j) { const int c = 4 * F.lane + 256 * j;
            const f32x4 g = *(const f32x4*)(F.g_ffn_pre + c), sh = *(const f32x4*)(mod + 3 * D + c), sc = *(const f32x4*)(mod + 4 * D + c);
            const f32x4 h = v[j] * rs2 * g * (sc + 1.0f) + sh;
            o8[64 * j] = (unsigned long long)pk2(h.x, h.y) | ((unsigned long long)pk2(h.z, h.w) << 32); }
    }
}

__device__ __forceinline__ void p8_conv_act(Ctx& F) {
    for (int r = blockIdx.x; r < MR; r += F.G) {
        const bool dec = r >= MP; const int bb = dec ? (r - MP) : (r >> 13), t = dec ? 0 : (r & (T - 1));
        const float* u2 = F.UP + (size_t)r * FF2;
        const float* u1; const float* u0; bool z1 = false, z0 = false;
        if (dec) { u0 = F.state_conv + (size_t)bb * 2 * FF2; u1 = u0 + FF2; }
        else { u1 = u2 - FF2; u0 = u2 - 2 * (size_t)FF2; z1 = (t < 1); z0 = (t < 2); }
        for (int j = F.tid; j < FF; j += NTHREADS) {
            const float a2 = u2[j], g2 = u2[j + FF];
            const float a1 = z1 ? 0.f : u1[j], g1 = z1 ? 0.f : u1[j + FF];
            const float a0 = z0 ? 0.f : u0[j], g0 = z0 ? 0.f : u0[j + FF];
            const float ca = F.conv_b[j] + F.conv_w[j] * a0 + F.conv_w[FF2 + j] * a1 + F.conv_w[2 * FF2 + j] * a2;
            const float cg = F.conv_b[j + FF] + F.conv_w[j + FF] * g0 + F.conv_w[FF2 + j + FF] * g1 + F.conv_w[2 * FF2 + j + FF] * g2;
            F.ACT[(size_t)r * FF + j] = (bf16)f2bf(silu_f(ca) * cg);
            if (dec) { float* o = F.out + O_CS + (size_t)bb * 2 * FF2; o[j] = a1; o[j + FF] = g1; o[FF2 + j] = a2; o[FF2 + j + FF] = g2; }
            else if (t >= T - 2) { float* o = F.out + O_CP + ((size_t)bb * 2 + (t - (T - 2))) * FF2; o[j] = a2; o[j + FF] = g2; }
        }
    }
}

__device__ __forceinline__ void p10_final(Ctx& F) {
    for (int r = F.gw; r < MR; r += F.NGW) {
        const f32x4* fr = (const f32x4*)(F.FFN + (size_t)r * D) + F.lane;
        const f32x4* x1 = (const f32x4*)(F.X1 + (size_t)r * D) + F.lane;
        const float* mod = F.MOD + (size_t)mod_row(r) * (6 * D);
        float* yo = (r < MP) ? F.out + O_YP + (size_t)r * D : F.out + O_YS + (size_t)(r - MP) * D;
        f32x4 v[4]; float ss = 0.f;
#pragma unroll
        for (int j = 0; j < 4; ++j) { v[j] = fr[64 * j]; ss += (v[j].x * v[j].x + v[j].y * v[j].y) + (v[j].z * v[j].z + v[j].w * v[j].w); }
        const float rs = 1.0f / sqrtf(wave_sum(ss) * (1.0f / D) + RMS_EPS);
#pragma unroll
        for (int j = 0; j < 4; ++j) { const int c = 4 * F.lane + 256 * j;
            const f32x4 g = *(const f32x4*)(F.g_ffn_post + c), gt = *(const f32x4*)(mod + 5 * D + c);
            *((f32x4*)yo + F.lane + 64 * j) = x1[64 * j] + gt * (v[j] * rs * g); }
    }
}


__device__ __forceinline__ void s1a_select(Ctx& F) {
    const int lane = F.lane, wid = F.wave, r32 = lane & 31, hi = lane >> 5;
    LAS unsigned* cnt = (LAS unsigned*)(F.lds);
    LAS unsigned short* lst = (LAS unsigned short*)(F.lds + 128);
    for (int u = blockIdx.x; u < NB * NH * NBLK_P; u += F.G) {
        const int bh = u >> 5, Qb = u & 31, b = bh >> 3, h = bh & 7;
        if (Qb == 0) continue;
        __syncthreads();
        if (F.tid < 32) cnt[F.tid] = 0u;
        const size_t row = (size_t)b * T + Qb * 256 + wid * 32 + r32;
        mb::bf16x8 qr[4];
#pragma unroll
        for (int d0 = 0; d0 < 4; ++d0) qr[d0] = *(const mb::bf16x8*)(F.QB + row * AW + h * HD + 16 * d0 + 8 * hi);
        mb::f32x16 g = {};
#pragma unroll
        for (int d0 = 0; d0 < 4; ++d0) {
            const float* km = F.KSUM + ((size_t)(b * NBLK_P + r32) * 2 * AW + h * HD + 16 * d0 + 8 * hi);
            const f32x4 a = (*(const f32x4*)km + *(const f32x4*)(km + AW)) * (1.0f / 256.0f), c = (*(const f32x4*)(km + 4) + *(const f32x4*)(km + AW + 4)) * (1.0f / 256.0f);
            const float x[8] = {a.x, a.y, a.z, a.w, c.x, c.y, c.z, c.w};
            mb::bf16x8 ah, al;
#pragma unroll
            for (int j = 0; j < 8; ++j) { const unsigned hb = f2bf(x[j]); const float rem = x[j] - __uint_as_float(hb << 16); ah[j] = (short)hb; al[j] = (short)f2bf(rem); }
            g = __builtin_amdgcn_mfma_f32_32x32x16_bf16(ah, qr[d0], g, 0, 0, 0);
            g = __builtin_amdgcn_mfma_f32_32x32x16_bf16(al, qr[d0], g, 0, 0, 0);
        }
        float v[16];
#pragma unroll
        for (int r = 0; r < 16; ++r) v[r] = (mb::crow(r, hi) < Qb) ? g[r] : -INFINITY;
        int sel[3];
#pragma unroll
        for (int k = 0; k < 3; ++k) {
            float bv = -INFINITY; int bi = 64;
#pragma unroll
            for (int r = 0; r < 16; ++r) if (v[r] > bv) { bv = v[r]; bi = mb::crow(r, hi); }
            const float pvv = __shfl_xor(bv, 32); const int pii = __shfl_xor(bi, 32);
            const bool tp = (pvv > bv) || (pvv == bv && pii < bi);
            const float wv = tp ? pvv : bv; const int wi = tp ? pii : bi;
            sel[k] = (wv == -INFINITY) ? -1 : wi;
#pragma unroll
            for (int r = 0; r < 16; ++r) if (mb::crow(r, hi) == wi) v[r] = -INFINITY;
        }
        __syncthreads();
        if (hi == 0) {
#pragma unroll
            for (int k = 0; k < 3; ++k) if (sel[k] >= 0) {
                const unsigned pos = __hip_atomic_fetch_add(cnt + sel[k], 1u, __ATOMIC_RELAXED, __HIP_MEMORY_SCOPE_WORKGROUP);
                lst[sel[k] * 256 + pos] = (unsigned short)((k << 8) | (wid * 32 + r32)); }
        }
        __syncthreads();
        { const int n = F.tid >> 4, part = F.tid & 15;
          if (n < Qb) { const size_t ub = ((size_t)(bh * 32 + n) * 32 + Qb);
              const LAS v4u* src = (const LAS v4u*)(lst + n * 256 + part * 16); GAS v4u* dst = (GAS v4u*)(F.LIST + ub * 256 + part * 16);
              dst[0] = src[0]; dst[1] = src[1];
              if (part == 0) F.COUNT[ub] = (int)cnt[n]; } }
    }
    __syncthreads();
}

__device__ __forceinline__ void s2_past(Ctx& F) {
    int lane = F.lane; const int wid = F.wave; int r32 = lane & 31, hi = lane >> 5;
    LAS unsigned char* misc = F.lds + mb::L_MISC;
    LAS int* PRE = (LAS int*)(misc + mb::M_PRE);
    LAS int* ROW = (LAS int*)(misc + mb::M_ROW);
    LAS int* WT = (LAS int*)(misc + mb::M_SCAL);
    const unsigned lds0 = (unsigned)(uintptr_t)F.lds;
    const mb::lds_cptr ldsc = (mb::lds_cptr)F.lds;
    {
        const int u = F.tid, n = u & 31; int L = 0; const int* cp = F.COUNT + (size_t)u * 32;
        for (int q = 0; q < 32; ++q) if (q > n) L += cp[q];
        int x = (L + 255) >> 8;
#pragma unroll
        for (int o = 1; o < 64; o <<= 1) { const int y = __shfl_up(x, o); if (lane >= o) x += y; }
        __syncthreads();
        if (lane == 63) WT[wid] = x;
        __syncthreads();
        int base = 0;
#pragma unroll
        for (int w = 0; w < 8; ++w) if (w < wid) base += WT[w];
        PRE[u + 1] = base + x; if (u == 0) PRE[0] = 0;
        __syncthreads();
    }
    const int NI = PRE[512];
    const int i0 = (int)((long long)NI * blockIdx.x / F.G), i1 = (int)((long long)NI * (blockIdx.x + 1) / F.G);
    int cur = -1;
    for (int it = i0; it < i1; ++it) {
        asm volatile("" : "+v"(lane)); r32 = lane & 31; hi = lane >> 5;
        int lo = 0, hi_ = 512;
        while (hi_ - lo > 1) { const int mid = (lo + hi_) >> 1; if (PRE[mid] <= it) lo = mid; else hi_ = mid; }
        const int u = __builtin_amdgcn_readfirstlane(lo), c = it - PRE[u], bh = u >> 5, n = u & 31, b = bh >> 3, h = bh & 7;
        if (u != cur) {
            __syncthreads();
            mb::stage_kv(F.KB, F.VB, (size_t)b * T + n * 256, h * HD, lds0, wid, lane);
            if (wid == 0) {
                int x = (lane < 32 && lane > n) ? F.COUNT[(size_t)u * 32 + lane] : 0;
#pragma unroll
                for (int o = 1; o < 32; o <<= 1) { const int y = __shfl_up(x, o); if (lane >= o) x += y; }
                if (lane < 32) ROW[lane + 1] = x;
                if (lane == 0) ROW[0] = 0;
            }
            asm volatile("s_waitcnt vmcnt(0) lgkmcnt(0)" ::: "memory");
            __syncthreads();
            cur = u;
        }
        const int Ltot = ROW[32];
        const int e = c * 256 + wid * 32 + r32; const bool valid = e < Ltot; const int ee = valid ? e : c * 256;
        int ql = 0, qh = 32;
#pragma unroll
        for (int s = 0; s < 5; ++s) { const int mid = (ql + qh) >> 1; if (ROW[mid] <= ee) ql = mid; else qh = mid; }
        const int Qb = ql, idx = ee - ROW[Qb];
        const unsigned ent = F.LIST[((size_t)u * 32 + Qb) * 256 + idx];
        const int slot = (int)(ent >> 8), tl = (int)(ent & 255u);
        const size_t row = (size_t)b * T + Qb * 256 + tl;
        mb::bf16x8 qr[4];
#pragma unroll
        for (int d0 = 0; d0 < 4; ++d0) qr[d0] = *(const mb::bf16x8*)(F.QB + row * AW + h * HD + 16 * d0 + 8 * hi);
        float m, l; mb::f32x16 o[2];
        mb::attend256<false>(qr, ldsc, lds0, lane, 0, 3, m, l, o);
        const int pidx = valid ? (int)((row * NH + h) * 3 + slot) : -1;
        if (valid && hi == 0) F.PM[pidx] = make_float2(m, l);
        LAS float* stg = (LAS float*)(F.lds + mb::L_STG + wid * mb::STG_W);
        mb::stage_o(o, stg, lane);
        LDS_WAIT(); asm volatile("" ::: "memory");
#pragma unroll
        for (int i = 0; i < 4; ++i) { const int q = i * 8 + (lane >> 3), ch = lane & 7; const int pq = __shfl(pidx, q);
            if (pq >= 0) { const f32x4 a0 = *(const LAS f32x4*)(stg + q * 68 + ch * 8), a1 = *(const LAS f32x4*)(stg + q * 68 + ch * 8 + 4);
                v4u w; w.x = pk2(a0.x, a0.y); w.y = pk2(a0.z, a0.w); w.z = pk2(a1.x, a1.y); w.w = pk2(a1.z, a1.w);
                *(GAS v4u*)(F.PO + (size_t)pq * 64 + ch * 8) = w; } }
        LDS_WAIT(); asm volatile("" ::: "memory");
    }
    __syncthreads();
}

__device__ __forceinline__ void s1b_own_merge(Ctx& F) {
    const int lane = F.lane, wid = F.wave, r32 = lane & 31, hi = lane >> 5;
    const unsigned lds0 = (unsigned)(uintptr_t)F.lds;
    const mb::lds_cptr ldsc = (mb::lds_cptr)F.lds;
    LAS float* wsf = (LAS float*)(F.lds + mb::L_MISC + mb::M_WSF) + wid * 64;
    LAS float* stg = (LAS float*)(F.lds + mb::L_STG + wid * mb::STG_W);
    for (int u = blockIdx.x; u < NB * NH * NBLK_P; u += F.G) {
        const int bh = u >> 5, Qb = u & 31, b = bh >> 3, h = bh & 7;
        __syncthreads();
        mb::stage_kv(F.KB, F.VB, (size_t)b * T + Qb * 256, h * HD, lds0, wid, lane);
        const size_t row0 = (size_t)b * T + Qb * 256 + wid * 32;
        mb::bf16x8 qr[4];
#pragma unroll
        for (int d0 = 0; d0 < 4; ++d0) qr[d0] = *(const mb::bf16x8*)(F.QB + (row0 + r32) * AW + h * HD + 16 * d0 + 8 * hi);
        asm volatile("s_waitcnt vmcnt(0) lgkmcnt(0)" ::: "memory");
        __syncthreads();
        float m, l; mb::f32x16 o[2];
        mb::attend256<true>(qr, ldsc, lds0, lane, wid * 32 + r32, wid >> 1, m, l, o);
        if (hi == 0) { wsf[r32] = m; wsf[32 + r32] = l; }
        mb::stage_o(o, stg, lane);
        LDS_WAIT(); asm volatile("" ::: "memory");
        const int nv = Qb < 3 ? Qb : 3;
#pragma unroll
        for (int i = 0; i < 4; ++i) { const int q = i * 8 + (lane >> 3), ch = lane & 7; const size_t rq = row0 + q; const size_t pb = (rq * NH + h) * 3;
            const float mo = wsf[q], lo_ = wsf[32 + q];
            f32x4 a0 = *(const LAS f32x4*)(stg + q * 68 + ch * 8), a1 = *(const LAS f32x4*)(stg + q * 68 + ch * 8 + 4);
            float2 ml[3]; float M = mo;
#pragma unroll
            for (int s = 0; s < 3; ++s) if (s < nv) { ml[s] = F.PM[pb + s]; M = fmaxf(M, ml[s].x); }
            const float f = __builtin_amdgcn_exp2f(mo - M); float Ls = f * lo_; a0 = a0 * f; a1 = a1 * f;
#pragma unroll
            for (int s = 0; s < 3; ++s) if (s < nv) { const float fs = __builtin_amdgcn_exp2f(ml[s].x - M); Ls += fs * ml[s].y;
                const v4u w = *(const GAS v4u*)(F.PO + (pb + s) * 64 + ch * 8);
                a0.x += fs * __uint_as_float(w.x << 16); a0.y += fs * __uint_as_float(w.x & 0xffff0000u); a0.z += fs * __uint_as_float(w.y << 16); a0.w += fs * __uint_as_float(w.y & 0xffff0000u);
                a1.x += fs * __uint_as_float(w.z << 16); a1.y += fs * __uint_as_float(w.z & 0xffff0000u); a1.z += fs * __uint_as_float(w.w << 16); a1.w += fs * __uint_as_float(w.w & 0xffff0000u); }
            const float inv = 1.0f / Ls; a0 = a0 * inv; a1 = a1 * inv;
            v4u w; w.x = pk2(a0.x, a0.y); w.y = pk2(a0.z, a0.w); w.z = pk2(a1.x, a1.y); w.w = pk2(a1.z, a1.w);
            *(GAS v4u*)(F.A2 + rq * D + 512 + h * HD + ch * 8) = w; }
        LDS_WAIT(); asm volatile("" ::: "memory");
    }
    __syncthreads();
}

#ifndef PROBE_ATT
#define PROBE_ATT 0
#endif
__device__ __forceinline__ void probe_att_compare(Ctx& F) {
    float sd = 0.f, sr = 0.f;
    for (int r = F.gw; r < MP; r += F.NGW) {
        for (int j = 0; j < 8; ++j) { const int c = j * 64 + F.lane;
            const float a = __uint_as_float((unsigned)F.A2[(size_t)r * D + 512 + c] << 16), ref = __uint_as_float((unsigned)F.A2REF[(size_t)r * AW + c] << 16);
            sd += (a - ref) * (a - ref); sr += ref * ref; }
    }
    sd = wave_sum(sd); sr = wave_sum(sr);
    if (F.lane == 0) { atomicAdd((float*)(F.ctl + 16), sd); atomicAdd((float*)(F.ctl + 17), sr); }
}

__device__ __forceinline__ void dec_gemm(Ctx& F, const bf16* A, const bf16* Bt, float* C, int ldc, int N, int K, int wg0, int nwg) {
    const int lane = F.lane, wid = F.wave, r32 = lane & 31, hi = lane >> 5, rt = wid & 3, kh = wid >> 2;
    const int me = (int)blockIdx.x - wg0;
    if (me < 0 || me >= nwg) return;
    LAS float* red = (LAS float*)F.lds;
    for (int du = me; du < N / 32; du += nwg) {
        const int n0 = du * 32;
        const bf16* ap = A + (size_t)(rt * 32 + r32) * K + kh * (K / 2) + 8 * hi;
        const bf16* bp = Bt + (size_t)(n0 + r32) * K + kh * (K / 2) + 8 * hi;
        mb::f32x16 acc = {};
#pragma unroll 8
        for (int k = 0; k < K / 2; k += 16) {
            const mb::bf16x8 a = *(const mb::bf16x8*)(ap + k), b = *(const mb::bf16x8*)(bp + k);
            acc = __builtin_amdgcn_mfma_f32_32x32x16_bf16(a, b, acc, 0, 0, 0);
        }
        __syncthreads();
        if (kh == 1) {
#pragma unroll
            for (int r = 0; r < 16; ++r) red[(rt * 16 + r) * 64 + lane] = acc[r];
        }
        __syncthreads();
        if (kh == 0) {
#pragma unroll
            for (int r = 0; r < 16; ++r) C[(size_t)(rt * 32 + mb::crow(r, hi)) * ldc + n0 + r32] = acc[r] + red[(rt * 16 + r) * 64 + lane];
        }
    }
    __syncthreads();
}

__device__ __forceinline__ void dec_att_partials(Ctx& F) {
    const int lane = F.lane;
    LAS float* qs = (LAS float*)(F.lds + 65536 + F.wave * 1024);
    LAS float* ps = qs + 64;
    for (int it = F.gw; it < DB * NH * 6; it += F.NGW) {
        const int bh = it / 6, sub = it - bh * 6, b = bh >> 3, h = bh & 7, ksel = sub >> 1, half = sub & 1;
        LDS_WAIT(); asm volatile("" ::: "memory");
        qs[lane] = F.QF[(size_t)(MP + b) * AW + h * HD + lane];
        LDS_WAIT(); asm volatile("" ::: "memory");
        float gate = -INFINITY;
        if (lane < NBLK_D) { const float* km = F.KMD + ((size_t)b * NBLK_D + lane) * AW + h * HD; float acc = 0.f;
#pragma unroll
            for (int d4 = 0; d4 < 16; ++d4) { const f32x4 kv = *(const f32x4*)(km + 4 * d4); const f32x4 qv = *(const LAS f32x4*)(qs + 4 * d4); acc += (kv.x * qv.x + kv.y * qv.y) + (kv.z * qv.z + kv.w * qv.w); }
            gate = acc; }
        int blk = 0;
#pragma unroll
        for (int k = 0; k < 3; ++k) { const float m = wave_max(gate); const unsigned long long bal = __ballot(gate == m); const int ix = __ffsll((long long)bal) - 1;
            if (k == ksel) blk = ix; if (lane == ix) gate = -INFINITY; }
        const int pg = F.page_table[b * NPAGES + 2 * blk + half];
        const float* kbase = F.cache_k + (size_t)pg * 128 * AW + h * HD;
        const float* vbase = F.cache_v + (size_t)pg * 128 * AW + h * HD;
        float s[2];
#pragma unroll
        for (int rr = 0; rr < 2; ++rr) { const float* kp = kbase + (size_t)(rr * 64 + lane) * AW; float acc = 0.f;
#pragma unroll
            for (int d4 = 0; d4 < 16; ++d4) { const f32x4 kv = *(const f32x4*)(kp + 4 * d4); const f32x4 qv = *(const LAS f32x4*)(qs + 4 * d4); acc += (kv.x * qv.x + kv.y * qv.y) + (kv.z * qv.z + kv.w * qv.w); }
            s[rr] = acc * 0.125f; }
        const float m = wave_max(fmaxf(s[0], s[1]));
        const float p0 = __expf(s[0] - m), p1 = __expf(s[1] - m);
        const float l = wave_sum(p0 + p1);
        ps[lane] = p0; ps[64 + lane] = p1;
        LDS_WAIT(); asm volatile("" ::: "memory");
        const int kq = lane >> 4, d4 = lane & 15;
        f32x4 acc = (f32x4){0.f, 0.f, 0.f, 0.f};
#pragma unroll 8
        for (int i = 0; i < 32; ++i) { const int key = i * 4 + kq; const f32x4 vv = *(const f32x4*)(vbase + (size_t)key * AW + d4 * 4); acc += vv * ps[key]; }
#pragma unroll
        for (int e = 0; e < 4; ++e) { float a = acc[e]; a += __shfl_xor(a, 16); a += __shfl_xor(a, 32); acc[e] = a; }
        if (lane < 16) *(f32x4*)(F.DPO + (size_t)it * HD + d4 * 4) = acc;
        if (lane == 0) F.DPM[it] = make_float2(m, l);
    }
}
__device__ __forceinline__ void dec_att_combine(Ctx& F) {
    const int lane = F.lane;
    for (int bh = F.gw; bh < DB * NH; bh += F.NGW) {
        const int b = bh >> 3, h = bh & 7;
        const float qv = F.QF[(size_t)(MP + b) * AW + h * HD + lane], kv = F.out[O_KS + (size_t)b * AW + h * HD + lane], vv = F.out[O_VS + (size_t)b * AW + h * HD + lane];
        const float so = wave_sum(qv * kv) * 0.125f;
        float2 ml[6]; float M = so;
#pragma unroll
        for (int i = 0; i < 6; ++i) { ml[i] = F.DPM[bh * 6 + i]; M = fmaxf(M, ml[i].x); }
        const float fo = __expf(so - M); float L = fo, acc = fo * vv;
#pragma unroll
        for (int i = 0; i < 6; ++i) { const float f = __expf(ml[i].x - M); L += f * ml[i].y; acc += f * F.DPO[(size_t)(bh * 6 + i) * HD + lane]; }
        F.A2[(size_t)(MP + b) * D + 512 + h * HD + lane] = (bf16)f2bf(acc / L);
    }
}

constexpr int N_PHASES = 13;
__global__ void __launch_bounds__(NTHREADS, 2) fwd(Args args) {
    extern __shared__ __attribute__((aligned(16))) unsigned char lds[];
    Ctx F;
    F.lds = (LAS unsigned char*)lds;
    F.tid = threadIdx.x; F.lane = F.tid & 63; F.wave = __builtin_amdgcn_readfirstlane(F.tid >> 6);
    F.G = gridDim.x; F.gw = blockIdx.x * NWAVES + F.wave; F.NGW = F.G * NWAVES;
    F.x_prompt = (const float*)args.in[0]; F.x_sample = (const float*)args.in[1]; F.c_prompt = (const float*)args.in[2]; F.c_sample = (const float*)args.in[3];
    F.cache_k = (const float*)args.in[4]; F.cache_v = (const float*)args.in[5]; F.page_table = (const int*)args.in[6]; F.state_pool = (const float*)args.in[7]; F.state_conv = (const float*)args.in[8];
    F.w_ada = (const float*)args.in[9]; F.b_ada = (const float*)args.in[10]; F.g_mix_pre = (const float*)args.in[11]; F.g_mix_post = (const float*)args.in[12]; F.w_in = (const float*)args.in[13];
    F.pool_w = (const float*)args.in[14]; F.pool_scale = (const float*)args.in[15]; F.w_out = (const float*)args.in[16]; F.g_ffn_pre = (const float*)args.in[17]; F.g_ffn_post = (const float*)args.in[18];
    F.w_up = (const float*)args.in[19]; F.conv_w = (const float*)args.in[20]; F.conv_b = (const float*)args.in[21]; F.w_down = (const float*)args.in[22];
    F.out = args.out;
    unsigned char* ws = args.ws;
    F.WIN = (bf16*)(ws + WS_WIN); F.WO2 = (bf16*)(ws + WS_WO2); F.WUP = (bf16*)(ws + WS_WUP); F.WDN = (bf16*)(ws + WS_WDN);
    F.MOD = (float*)(ws + WS_MOD); F.ROPE = (float2*)(ws + WS_ROPE); F.KMD = (float*)(ws + WS_KMD); F.KMP = (float*)(ws + WS_KMP);
    F.XN = (bf16*)(ws + WS_XN); F.PROJ = (float*)(ws + WS_PROJ); F.QF = (float*)(ws + WS_QF); F.A2 = (bf16*)(ws + WS_A2); F.MIX = (float*)(ws + WS_MIX);
    F.QB = (bf16*)(ws + WS_QB); F.KB = (bf16*)(ws + WS_KB); F.VB = (bf16*)(ws + WS_VB); F.LIST = (unsigned short*)(ws + WS_LIST); F.COUNT = (int*)(ws + WS_COUNT); F.PO = (bf16*)(ws + WS_PO); F.PM = (float2*)(ws + WS_PM); F.A2REF = (bf16*)(ws + WS_A2REF); F.ctl = (unsigned*)(ws + WS_CTL); F.U = (float*)(ws + WS_U); F.KSUM = (float*)(ws + WS_KSUM); F.DPO = (float*)(ws + WS_DPO); F.DPM = (float2*)(ws + WS_DPM);
    F.X1 = (float*)(ws + WS_X1); F.UP = (float*)(ws + WS_UP); F.ACT = (bf16*)(ws + WS_ACT); F.FFN = (float*)(ws + WS_FFN);

    volatile LAS unsigned* MISC = (volatile LAS unsigned*)(F.lds + MISC_OFF);
    for (int u = F.tid; u < (LDS_BYTES - LDSCTL_OFF) / 4; u += NTHREADS) ((LAS unsigned*)(F.lds + LDSCTL_OFF))[u] = 0u;
    __syncthreads();
    const int lo = args.ph_lo, hi = args.ph_hi;
    const bool multi = (hi - lo) > 1;
    XcdBarrier bar; bar.bar = (unsigned*)(ws + WS_CTL) + CW_BAR; bar.x = 0; bar.st = nullptr;
    if (multi) bar = xcd_barrier_post((unsigned*)(ws + WS_CTL) + CW_BAR, MISC + 8);
#define IN(k) (lo <= (k) && (k) < hi)
#define SEAM(k) do { if (IN(k) && IN((k) + 1)) xcd_barrier(bar); } while (0)

#ifndef PROBE_DUP
#define PROBE_DUP 0
#endif
#define DUP(k) (((PROBE_DUP) >> (k)) & 1)
#define RUNP(k, ...) if (IN(k)) { asm volatile("" : "+v"(F.lane), "+v"(F.tid)); __VA_ARGS__; if (DUP(k)) { __syncthreads(); __VA_ARGS__; } } SEAM(k);
#define GEMM_F32(Aop, Bop, Cout, Nn, Kk, W0, NW) { pg8::Gemm g{Aop, Bop, MP, Nn, Kk}; pg8::StaticOrder S; S.init(MP, Nn, F.G, (int)blockIdx.x); pg8::EpiF32 E{Cout, Nn, nullptr}; \
        pg8::gemm_phase<pg8::EpiF32, pg8::StaticOrder, PG8_ALIGN, PG8_SP2>(F.lds, g, S, E); \
        dec_gemm(F, (Aop) + (size_t)MP * (Kk), Bop, (Cout) + (size_t)MP * (Nn), Nn, Nn, Kk, W0, NW); }
    RUNP(0, p0_prologue(F))
    RUNP(1, p1_norm_in(F))
    RUNP(2, { pg8::Gemm g{F.XN, F.WIN, MP, INW, D}; pg8::StaticOrder S; S.init(MP, INW, F.G, (int)blockIdx.x);
        pg8::EpiProj E{F.U, F.QB, F.KB, F.VB, F.out + O_KP, F.out + O_VP, F.KSUM, (const float*)F.ROPE, mb::C2};
        pg8::gemm_phase<pg8::EpiProj, pg8::StaticOrder, PG8_ALIGN, PG8_SP2>(F.lds, g, S, E);
        dec_gemm(F, F.XN + (size_t)MP * D, F.WIN, F.PROJ + (size_t)MP * INW, INW, INW, D, 0, 256); })
    RUNP(3, p3_post_proj(F); p3_pool_prompt(F))
#if PROBE_ATT
    RUNP(4, s1a_select(F); p4_attention_naive<false>(F); p4_attention_naive<true>(F))
#else
    RUNP(4, s1a_select(F); dec_att_partials(F))
#endif
    RUNP(5, dec_att_combine(F); s2_past(F))
    RUNP(6, s1b_own_merge(F))
    RUNP(7, GEMM_F32(F.A2, F.WO2, F.MIX, D, D, 0, 256))
#if PROBE_ATT
    RUNP(8, p6_mid_norm(F); probe_att_compare(F))
#else
    RUNP(8, p6_mid_norm(F))
#endif
    RUNP(9, GEMM_F32(F.XN, F.WUP, F.UP, FF2, D, 128, 128))
    RUNP(10, p8_conv_act(F))
    RUNP(11, GEMM_F32(F.ACT, F.WDN, F.FFN, D, FF, 0, 256))
    if (IN(12)) { asm volatile("" : "+v"(F.lane), "+v"(F.tid)); p10_final(F); if (DUP(12)) p10_final(F);
#if PROBE_ATT
        if (blockIdx.x == 0 && F.tid == 0) { const float sd = __hip_atomic_load((float*)(F.ctl + 16), __ATOMIC_RELAXED, __HIP_MEMORY_SCOPE_AGENT), sr = __hip_atomic_load((float*)(F.ctl + 17), __ATOMIC_RELAXED, __HIP_MEMORY_SCOPE_AGENT);
            F.out[O_PP] += 100.0f * sqrtf(sd / fmaxf(sr, 1e-30f)); }
#endif
    }
#undef IN
#undef SEAM
}

#ifndef MK_ONE_LAUNCH
#define MK_ONE_LAUNCH 1
#endif
extern "C" void kernel_launch(void* const* d_in, const int* in_sizes, int n_in, void* d_out, int out_size, void* d_ws, size_t ws_size, hipStream_t stream) {
    static int grid = 0;
    if (grid == 0) {
        if (n_in != 23 || out_size != (int)O_END || ws_size < WS_END) { fprintf(stderr, "kernel_launch: unexpected shapes n_in %d out %d ws %zu\n", n_in, out_size, ws_size); grid = -1; return; }
        int dev = 0, cus = 0;
        if (hipGetDevice(&dev) != hipSuccess || hipDeviceGetAttribute(&cus, hipDeviceAttributeMultiprocessorCount, dev) != hipSuccess) { grid = -1; return; }
        if (hipFuncSetAttribute((const void*)fwd, hipFuncAttributeMaxDynamicSharedMemorySize, LDS_BYTES) != hipSuccess) { fprintf(stderr, "kernel_launch: hipFuncSetAttribute failed\n"); grid = -1; return; }
        int per_cu = 0;
        if (hipOccupancyMaxActiveBlocksPerMultiprocessor(&per_cu, (const void*)fwd, NTHREADS, LDS_BYTES) != hipSuccess || per_cu < 1) fprintf(stderr, "kernel_launch: occupancy query says %d\n", per_cu);
        (void)hipGetLastError();
        grid = cus;
    }
    if (grid < 0) return;
    (void)hipMemsetAsync((char*)d_ws + WS_CTL, 0, CTL_ZERO_BYTES, stream);
    Args a{};
    for (int i = 0; i < 23; ++i) a.in[i] = d_in[i];
    a.out = (float*)d_out; a.ws = (unsigned char*)d_ws;
#if MK_ONE_LAUNCH
    a.ph_lo = 0; a.ph_hi = N_PHASES;
    hipLaunchKernelGGL(fwd, dim3(grid), dim3(NTHREADS), LDS_BYTES, stream, a);
#else
    for (int p = 0; p < N_PHASES; ++p) { a.ph_lo = p; a.ph_hi = p + 1; hipLaunchKernelGGL(fwd, dim3(grid), dim3(NTHREADS), LDS_BYTES, stream, a); }
#endif
}
```

```cpp
#include <hip/hip_runtime.h>
#include <cstdio>
#include <cstdint>
namespace pg8 {
#define PG8_LAS __attribute__((address_space(3)))
typedef unsigned short bf16_t;
typedef short bf16x8 __attribute__((ext_vector_type(8)));
typedef float f32x4 __attribute__((ext_vector_type(4)));
typedef unsigned u32x4 __attribute__((ext_vector_type(4)));
constexpr int BM = 256, BK = 64, HALF = 128, HTB = HALF * BK * 2  , STAGE_BYTES = 8 * HTB, NXCD = 8, WGM = 8;

__host__ __device__ __forceinline__ int lds_byte(int r, int c) { const int st = (r >> 4) * 2 + (c >> 5), rr = r & 15, cc = c & 31, ob = rr * 64 + cc * 2; return st * 1024 + (ob ^ (((ob >> 9) & 1) << 5)); }
__host__ __device__ __forceinline__ void stage_rc(int b, int& R, int& C) { const int st = b / 1024, sb = b % 1024, swz = sb ^ (((sb >> 9) & 1) << 5); R = (st >> 1) * 16 + swz / 64; C = (st & 1) * 32 + (swz % 64) / 2; }
__host__ __device__ __forceinline__ int perm32(int rho) { const int n = rho >> 4, i = rho & 15; return 8 * (i >> 2) + 4 * n + (i & 3); }

struct Unit { int pm, pn; };
struct Gemm { const bf16_t* A; const bf16_t* Bt; int M, N, K; };

struct StaticOrder {
    int nM, nN, nwg, G, c;
    __host__ __device__ void init(int M, int N, int G_, int c_) { nM = M / BM; nN = N / BM; nwg = nM * nN; G = G_; c = c_; }
    __host__ __device__ bool next(int i, Unit& u) const {
        const long L = (long)i * G + c; if (L >= nwg) return false;
        int wgid = (int)L; { const int q = nwg / NXCD, r = nwg % NXCD, xcd = wgid % NXCD, off = wgid / NXCD; wgid = (xcd < r ? xcd * (q + 1) : r * (q + 1) + (xcd - r) * q) + off; }
        const int nig = WGM * nN, gid = wgid / nig, fm = gid * WGM, gsz = (nM - fm) < WGM ? (nM - fm) : WGM;
        u.pm = fm + ((wgid % nig) % gsz); u.pn = (wgid % nig) / gsz; return true;
    }
    __device__ __forceinline__ void a_ready(const Unit&) const {}
    __device__ __forceinline__ void done(const Unit&) const {}
    __device__ __forceinline__ int a_row(const Unit& u) const { return u.pm * BM; }
};

__device__ __forceinline__ unsigned cvt_pk_bf16(float lo, float hi) { unsigned r; asm volatile("v_cvt_pk_bf16_f32 %0, %1, %2" : "=v"(r) : "v"(lo), "v"(hi)); return r; }
typedef float f32x2 __attribute__((ext_vector_type(2)));
__device__ __forceinline__ f32x2 gelu_pk(f32x2 v) {
    const f32x2 av = __builtin_elementwise_abs(v), d = av * 0.2316418882f + 1.0f;
    f32x2 t; t.x = __builtin_amdgcn_rcpf(d.x); t.y = __builtin_amdgcn_rcpf(d.y);
    f32x2 q = t * 0.5307027145f + (-0.7265760135f); q = q * t + 0.7107068705f; q = q * t + (-0.142248368f); q = q * t + 0.127414796f; q = q * t;
    const f32x2 s = (v * v) * (-0.72134752044f);
    f32x2 e; e.x = __builtin_amdgcn_exp2f(s.x); e.y = __builtin_amdgcn_exp2f(s.y);
    const f32x2 m = v * (q * e), r = v - m;
    f32x2 o; o.x = v.x < 0.f ? m.x : r.x; o.y = v.y < 0.f ? m.y : r.y; return o;
}

template <int ACT  > struct EpiBf16 {
    static constexpr bool PERM = true, AFTER_DRAIN = false; static_assert(ACT == 0 || ACT == 1, "EpiBf16: ACT is 0 (none) or 1 (gelu_pk)");
    bf16_t* O; int ldc; const float* bias; int split_cols; size_t split_stride; float scale0;
    __device__ __forceinline__ void operator()(const f32x4 (&acc)[2][2][4][2], const Unit& u, int wr, int wc, int fr, int fq) const {
        const int row0 = u.pm * BM + wr * 64 + fr; int colt = u.pn * BM; bf16_t* base = O;
        float sc = 1.f; if (split_cols) { const int t = colt / split_cols; base += (size_t)t * split_stride; colt -= t * split_cols; if (t == 0) sc = scale0; }
        const int col0 = colt + wc * 32 + 8 * fq, bcol0 = u.pn * BM + wc * 32 + 8 * fq;
        f32x4 bv[2][2];
#pragma unroll
        for (int bj = 0; bj < 2; ++bj)
#pragma unroll
            for (int n = 0; n < 2; ++n) bv[bj][n] = bias ? *(const f32x4*)(bias + bcol0 + bj * HALF + 4 * n) : (f32x4){0.f, 0.f, 0.f, 0.f};
#pragma unroll
        for (int ai = 0; ai < 2; ++ai)
#pragma unroll
            for (int m = 0; m < 4; ++m) { bf16_t* rowp = base + (size_t)(row0 + ai * HALF + m * 16) * ldc + col0;
#pragma unroll
                for (int bj = 0; bj < 2; ++bj) { f32x4 v0 = acc[ai][bj][m][0] + bv[bj][0], v1 = acc[ai][bj][m][1] + bv[bj][1];
                    if (ACT == 1) { f32x2 a = gelu_pk((f32x2){v0[0], v0[1]}), b = gelu_pk((f32x2){v0[2], v0[3]}), c = gelu_pk((f32x2){v1[0], v1[1]}), d = gelu_pk((f32x2){v1[2], v1[3]});
                        v0 = (f32x4){a.x, a.y, b.x, b.y}; v1 = (f32x4){c.x, c.y, d.x, d.y}; }
                    v0 = v0 * sc; v1 = v1 * sc; u32x4 w; w.x = cvt_pk_bf16(v0[0], v0[1]); w.y = cvt_pk_bf16(v0[2], v0[3]); w.z = cvt_pk_bf16(v1[0], v1[1]); w.w = cvt_pk_bf16(v1[2], v1[3]);
                    *(u32x4*)(rowp + bj * HALF) = w; } }
    }
};

struct PanelStats {
    unsigned* xbuf;
    unsigned* cnt;
    unsigned* tmo;
    int ntn; float eps;
    unsigned code;
    __device__ __forceinline__ bool run(const f32x4 (&v)[2][2][4][2], const Unit& u, int wr, int wc, int fr, int fq, PG8_LAS unsigned char* lds, int wid, int lane) const {
        typedef float f32x2v __attribute__((ext_vector_type(2)));
        PG8_LAS f32x2v* P = (PG8_LAS f32x2v*)lds;
        PG8_LAS f32x2v* S = (PG8_LAS f32x2v*)(lds + 8192);
        PG8_LAS unsigned* flag = (PG8_LAS unsigned*)(lds + 8192 + 2048);
#pragma unroll
        for (int ai = 0; ai < 2; ++ai)
#pragma unroll
            for (int m = 0; m < 4; ++m) {
                float s = 0.f;
#pragma unroll
                for (int bj = 0; bj < 2; ++bj)
#pragma unroll
                    for (int n = 0; n < 2; ++n) { const f32x4 x = v[ai][bj][m][n]; s += (x[0] + x[1]) + (x[2] + x[3]); }
                s += __shfl_xor(s, 16); s += __shfl_xor(s, 32);
                const float mw = s * (1.0f / 64.0f); float q = 0.f;
#pragma unroll
                for (int bj = 0; bj < 2; ++bj)
#pragma unroll
                    for (int n = 0; n < 2; ++n) { const f32x4 d = v[ai][bj][m][n] - mw; q += (d[0] * d[0] + d[1] * d[1]) + (d[2] * d[2] + d[3] * d[3]); }
                q += __shfl_xor(q, 16); q += __shfl_xor(q, 32);
                if (fq == 0) P[(ai * HALF + wr * 64 + m * 16 + fr) * 4 + wc] = (f32x2v){mw, q};
            }
        asm volatile("s_waitcnt lgkmcnt(0)" ::: "memory"); __builtin_amdgcn_s_barrier(); asm volatile("" ::: "memory");
#if defined(BROKEN_EXCHANGE_NO_WAIT)
#warning BROKEN CONTROL BUILD: the row-statistics exchange does not wait; results are wrong by design
        if (blockIdx.x >= 64) { const long long t0_ = clock64(); while (clock64() - t0_ < 60000) __builtin_amdgcn_s_sleep(8); }
#endif
        const int row = wid * 32 + (lane & 31);
        if (lane < 32) {
            const f32x2v a = P[row * 4 + 0], b = P[row * 4 + 1], c = P[row * 4 + 2], d = P[row * 4 + 3];
            const float mt = (a.x + b.x + c.x + d.x) * 0.25f;
            const float da = a.x - mt, db = b.x - mt, dc = c.x - mt, dd = d.x - mt;
            const float m2 = (a.y + b.y) + (c.y + d.y) + 64.0f * ((da * da + db * db) + (dc * dc + dd * dd));
            unsigned long long* slot = (unsigned long long*)xbuf + ((size_t)(u.pm * BM + row) * 4 + u.pn);
            __hip_atomic_store(slot, ((unsigned long long)__float_as_uint(m2) << 32) | __float_as_uint(mt), __ATOMIC_RELAXED, __HIP_MEMORY_SCOPE_AGENT);
        }
        asm volatile("s_waitcnt vmcnt(0)" ::: "memory");
        if (lane == 0) __hip_atomic_fetch_add(cnt + 64 * u.pm, 1u, __ATOMIC_RELAXED, __HIP_MEMORY_SCOPE_AGENT);
        if (wid == 0) {
            bool dead = false; const unsigned long long t0 = __builtin_amdgcn_s_memrealtime(); const unsigned want = 8u * (unsigned)ntn;
            for (;;) {
#if defined(BROKEN_EXCHANGE_NO_WAIT)
                break;
#endif
                if ((unsigned)__builtin_amdgcn_readfirstlane(__hip_atomic_load(cnt + 64 * u.pm, __ATOMIC_RELAXED, __HIP_MEMORY_SCOPE_AGENT)) >= want) break;
                if (__builtin_amdgcn_s_memrealtime() - t0 > 2000000ull) {
                    if (lane == 0) { unsigned expect = 0u; __hip_atomic_compare_exchange_strong(tmo + 1, &expect, code | (unsigned)(u.pm & 0xff), __ATOMIC_RELAXED, __ATOMIC_RELAXED, __HIP_MEMORY_SCOPE_AGENT);
                                     __hip_atomic_store(tmo, 1u, __ATOMIC_RELAXED, __HIP_MEMORY_SCOPE_AGENT); }
                    dead = true; break; }
                __builtin_amdgcn_s_sleep(2);
            }
            __builtin_amdgcn_fence(__ATOMIC_ACQUIRE, "agent");
            if (lane == 0) flag[0] = dead ? 1u : 0u;
        }
        asm volatile("s_waitcnt vmcnt(0) lgkmcnt(0)" ::: "memory"); __builtin_amdgcn_s_barrier(); asm volatile("" ::: "memory");
        const bool bad = flag[0] != 0u;
        if (lane < 32) {
            const unsigned long long* slot = (const unsigned long long*)xbuf + (size_t)(u.pm * BM + row) * 4; float mt[4], m2[4]; float ms = 0.f;
#pragma unroll
            for (int t = 0; t < 4; ++t) { if (t < ntn) { const unsigned long long w = __hip_atomic_load(slot + t, __ATOMIC_RELAXED, __HIP_MEMORY_SCOPE_AGENT); mt[t] = __uint_as_float((unsigned)w); m2[t] = __uint_as_float((unsigned)(w >> 32)); } else { mt[t] = 0.f; m2[t] = 0.f; } ms += mt[t]; }
            const float mean = ms / (float)ntn; float q = 0.f;
#pragma unroll
            for (int t = 0; t < 4; ++t) if (t < ntn) { const float dm = mt[t] - mean; q += m2[t] + 256.0f * dm * dm; }
            S[row] = (f32x2v){mean, 1.0f / sqrtf(q / (256.0f * (float)ntn) + eps)};
        }
        asm volatile("s_waitcnt lgkmcnt(0)" ::: "memory"); __builtin_amdgcn_s_barrier(); asm volatile("" ::: "memory");
        return bad;
    }
};
struct EpiLnRes {
    static constexpr bool PERM = false, AFTER_DRAIN = true;
    const float* base; float* out; int ldc; const float* bias; PanelStats st; unsigned poison;
    __device__ __forceinline__ void fused(f32x4 (&acc)[2][2][4][2], const Unit& u, int wr, int wc, int fr, int fq, PG8_LAS unsigned char* lds, int wid, int lane) const {
        typedef float f32x2v __attribute__((ext_vector_type(2)));
        const PG8_LAS f32x2v* S = (const PG8_LAS f32x2v*)(lds + 8192);
        const int col0 = u.pn * BM + wc * 32 + 4 * fq;
#pragma unroll
        for (int bj = 0; bj < 2; ++bj)
#pragma unroll
            for (int n = 0; n < 2; ++n) { const f32x4 bv = bias ? *(const f32x4*)(bias + col0 + bj * HALF + n * 16) : (f32x4){0.f, 0.f, 0.f, 0.f};
#pragma unroll
                for (int ai = 0; ai < 2; ++ai)
#pragma unroll
                    for (int m = 0; m < 4; ++m) acc[ai][bj][m][n] += bv; }
        f32x4 pre[4][2][2];
#pragma unroll
        for (int m = 0; m < 4; ++m) { const size_t off = (size_t)(u.pm * BM + wr * 64 + m * 16 + fr) * ldc + col0;
#pragma unroll
            for (int bj = 0; bj < 2; ++bj)
#pragma unroll
                for (int n = 0; n < 2; ++n) pre[m][bj][n] = *(const f32x4*)(base + off + bj * HALF + n * 16); }
        const bool bad = st.run(acc, u, wr, wc, fr, fq, lds, wid, lane) || poison != 0u;
        const float qnan = __builtin_nanf("");
#pragma unroll
        for (int ai = 0; ai < 2; ++ai)
#pragma unroll
            for (int m = 0; m < 4; ++m) { const int r = ai * HALF + wr * 64 + m * 16 + fr; const f32x2v sr = S[r]; const size_t off = (size_t)(u.pm * BM + r) * ldc + col0;
#pragma unroll
                for (int bj = 0; bj < 2; ++bj)
#pragma unroll
                    for (int n = 0; n < 2; ++n) { const f32x4 bs = ai == 0 ? pre[m][bj][n] : *(const f32x4*)(base + off + bj * HALF + n * 16); f32x4 o = bs + (acc[ai][bj][m][n] - sr.x) * sr.y;
                        if (bad) o = (f32x4){qnan, qnan, qnan, qnan}; *(f32x4*)(out + off + bj * HALF + n * 16) = o; }
                if (m & 1) asm volatile("" ::: "memory"); }
    }
};
struct EpiLnResLn {
    static constexpr bool PERM = false, AFTER_DRAIN = true;
    const float* base; float* out; bf16_t* xn; int ldc; const float* bias; PanelStats st1, st2; unsigned poison;
    __device__ __forceinline__ void fused(f32x4 (&acc)[2][2][4][2], const Unit& u, int wr, int wc, int fr, int fq, PG8_LAS unsigned char* lds, int wid, int lane) const {
        typedef float f32x2v __attribute__((ext_vector_type(2))); typedef unsigned u32x2v __attribute__((ext_vector_type(2)));
        const PG8_LAS f32x2v* S = (const PG8_LAS f32x2v*)(lds + 8192);
        const int col0 = u.pn * BM + wc * 32 + 4 * fq;
#pragma unroll
        for (int bj = 0; bj < 2; ++bj)
#pragma unroll
            for (int n = 0; n < 2; ++n) { const f32x4 bv = bias ? *(const f32x4*)(bias + col0 + bj * HALF + n * 16) : (f32x4){0.f, 0.f, 0.f, 0.f};
#pragma unroll
                for (int ai = 0; ai < 2; ++ai)
#pragma unroll
                    for (int m = 0; m < 4; ++m) acc[ai][bj][m][n] += bv; }
        bool bad = st1.run(acc, u, wr, wc, fr, fq, lds, wid, lane) || poison != 0u;
        const float qnan = __builtin_nanf("");
#pragma unroll
        for (int ai = 0; ai < 2; ++ai)
#pragma unroll
            for (int m = 0; m < 4; ++m) { const int r = ai * HALF + wr * 64 + m * 16 + fr; const f32x2v sr = S[r]; const size_t off = (size_t)(u.pm * BM + r) * ldc + col0;
#pragma unroll
                for (int bj = 0; bj < 2; ++bj)
#pragma unroll
                    for (int n = 0; n < 2; ++n) { const f32x4 bs = *(const f32x4*)(base + off + bj * HALF + n * 16); acc[ai][bj][m][n] = bs + (acc[ai][bj][m][n] - sr.x) * sr.y; }
                asm volatile("" : "+v"(acc[ai][0][m][0]), "+v"(acc[ai][0][m][1]), "+v"(acc[ai][1][m][0]), "+v"(acc[ai][1][m][1]));
                if (m & 1) asm volatile("" ::: "memory"); }
        const bool bad1 = bad;
        bad = st2.run(acc, u, wr, wc, fr, fq, lds, wid, lane) || bad;
#pragma unroll
        for (int ai = 0; ai < 2; ++ai)
#pragma unroll
            for (int m = 0; m < 4; ++m) { const int r = ai * HALF + wr * 64 + m * 16 + fr; const f32x2v sr = S[r]; const size_t off = (size_t)(u.pm * BM + r) * ldc + col0;
#pragma unroll
                for (int bj = 0; bj < 2; ++bj)
#pragma unroll
                    for (int n = 0; n < 2; ++n) { const f32x4 x1 = acc[ai][bj][m][n]; *(f32x4*)(out + off + bj * HALF + n * 16) = bad1 ? (f32x4){qnan, qnan, qnan, qnan} : x1;
                        const f32x4 o = (x1 - sr.x) * sr.y; u32x2v w; w.x = cvt_pk_bf16(o[0], o[1]); w.y = cvt_pk_bf16(o[2], o[3]);
                        if (bad) { w.x = 0x7fc07fc0u; w.y = 0x7fc07fc0u; } *(u32x2v*)(xn + off + bj * HALF + n * 16) = w; }
                asm volatile("" ::: "memory"); }
    }
};

template <class Epi, class Sched, bool ALIGN_EPI = false, bool SP2 = false>
__device__ __forceinline__ void gemm_phase(PG8_LAS unsigned char* lds, const Gemm g, const Sched& S, const Epi& E) {
    const int tid = threadIdx.x, wid = __builtin_amdgcn_readfirstlane(tid >> 6), lane = tid & 63, wr = wid >> 2, wc = wid & 3, fr = lane & 15, fq = lane >> 4;
    const int K = g.K, nt = K / BK;
    unsigned voffA[2], voffB[2];
#pragma unroll
    for (int i = 0; i < 2; ++i) { int R, C; stage_rc(tid * 16 + i * 8192, R, C); const int Rb = Epi::PERM ? ((R & ~31) + perm32(R & 31)) : R;
        voffA[i] = (unsigned)(R * K + C) * 2u; voffB[i] = (unsigned)(Rb * K + C) * 2u; }
    const size_t kstep = (size_t)(BK * 2);
    const size_t hstep = (size_t)HALF * K * 2;
    const size_t tstep = 2 * hstep;
    const unsigned ldsw = (unsigned)wid * 1024u;
    const int aoff = lds_byte(wr * 64 + fr, fq * 8), boff = lds_byte(wc * 32 + fr, fq * 8);
#define PG8_SA(b, h) (((b) * 2 + (h)) * HTB)
#define PG8_SB(b, h) ((4 + (b) * 2 + (h)) * HTB)
#define PG8_STAGE(bufoff, gbase, voff) do { _Pragma("unroll") for (int _i = 0; _i < 2; ++_i) \
        __builtin_amdgcn_global_load_lds((const unsigned*)((const char*)(gbase) + (voff)[_i]), (PG8_LAS unsigned*)(lds + (bufoff) + ldsw + _i * 8192), 16, 0, 0); } while (0)
#define PG8_LDA(dst, b, h) do { _Pragma("unroll") for (int m = 0; m < 4; ++m) _Pragma("unroll") for (int k = 0; k < 2; ++k) dst[m][k] = *(const PG8_LAS bf16x8*)(lds + PG8_SA(b, h) + aoff + m * 2048 + k * 1024); } while (0)
#define PG8_LDB(dst, b, h) do { _Pragma("unroll") for (int n = 0; n < 2; ++n) _Pragma("unroll") for (int k = 0; k < 2; ++k) dst[n][k] = *(const PG8_LAS bf16x8*)(lds + PG8_SB(b, h) + boff + n * 2048 + k * 1024); } while (0)
#define PG8_MMA(ai, bj, At, Bt) do { __builtin_amdgcn_s_setprio(1); _Pragma("unroll") for (int m = 0; m < 4; ++m) _Pragma("unroll") for (int n = 0; n < 2; ++n) _Pragma("unroll") for (int k = 0; k < 2; ++k) \
        acc[ai][bj][m][n] = __builtin_amdgcn_mfma_f32_16x16x32_bf16(Bt[n][k], At[m][k], acc[ai][bj][m][n], 0, 0, 0); __builtin_amdgcn_s_setprio(0); } while (0)
#define PG8_WAIT_V(n) asm volatile("s_waitcnt vmcnt(" #n ")" ::: "memory")
#define PG8_WAIT_L(n) asm volatile("s_waitcnt lgkmcnt(" #n ")" ::: "memory")
#define PG8_BAR __builtin_amdgcn_s_barrier()
#define PG8_SCHED __builtin_amdgcn_sched_barrier(0)
    Unit cur, nxt; int ui = 0;
    if (!S.next(0, cur)) return;
    f32x4 acc[2][2][4][2];
#pragma unroll
    for (int a = 0; a < 2; ++a)
#pragma unroll
        for (int b = 0; b < 2; ++b)
#pragma unroll
            for (int m = 0; m < 4; ++m)
#pragma unroll
                for (int n = 0; n < 2; ++n) acc[a][b][m][n] = (f32x4){0.f, 0.f, 0.f, 0.f};
    bf16x8 At[4][2], B0[2][2], B1[2][2];
    const char* cA = (const char*)g.A + (size_t)S.a_row(cur) * (size_t)(K * 2); const char* cB = (const char*)g.Bt + (size_t)cur.pn * tstep;
    S.a_ready(cur);
    if constexpr (SP2) {
        PG8_STAGE(PG8_SB(0, 0), cB, voffB); PG8_STAGE(PG8_SB(0, 1), cB + hstep, voffB); PG8_STAGE(PG8_SA(0, 0), cA, voffA); PG8_STAGE(PG8_SA(0, 1), cA + hstep, voffA);
        if (wr == 1) PG8_BAR;
        PG8_WAIT_V(2); PG8_BAR;
        PG8_STAGE(PG8_SB(1, 0), cB + kstep, voffB); PG8_STAGE(PG8_SA(1, 0), cA + kstep, voffA); PG8_STAGE(PG8_SB(1, 1), cB + hstep + kstep, voffB);
        PG8_WAIT_V(6); PG8_BAR;
    } else {
        PG8_STAGE(PG8_SB(0, 0), cB, voffB); PG8_STAGE(PG8_SA(0, 0), cA, voffA); PG8_STAGE(PG8_SB(0, 1), cB + hstep, voffB); PG8_STAGE(PG8_SA(0, 1), cA + hstep, voffA);
        if (wr == 1) PG8_BAR;
        PG8_WAIT_V(4); PG8_BAR;
        PG8_STAGE(PG8_SB(1, 0), cB + kstep, voffB); PG8_STAGE(PG8_SA(1, 0), cA + kstep, voffA); PG8_STAGE(PG8_SB(1, 1), cB + hstep + kstep, voffB);
        PG8_WAIT_V(6); PG8_BAR;
    }
    for (;;) {
        const bool has_next = S.next(ui + 1, nxt);
        const char* nA = has_next ? (const char*)g.A + (size_t)S.a_row(nxt) * (size_t)(K * 2) : cA; const char* nB = has_next ? (const char*)g.Bt + (size_t)nxt.pn * tstep : cB;
        for (int t = 0; t < nt; t += 2) {
            const bool last = (t == nt - 2);
            const char* a1 = cA + (size_t)(t + 1) * kstep;
            const char* a2 = last ? nA : cA + (size_t)(t + 2) * kstep; const char* b2 = last ? nB : cB + (size_t)(t + 2) * kstep;
            const char* a3 = a2 + kstep; const char* b3 = b2 + kstep;
            if (last && has_next) S.a_ready(nxt);
            if constexpr (SP2) {
            PG8_LDB(B0, 0, 0); PG8_LDB(B1, 0, 1); PG8_SCHED; PG8_LDA(At, 0, 0); PG8_STAGE(PG8_SA(1, 1), a1 + hstep, voffA);
            PG8_WAIT_V(8); PG8_WAIT_L(0); PG8_BAR; PG8_MMA(0, 0, At, B0); PG8_MMA(0, 1, At, B1); PG8_BAR; PG8_SCHED;
            PG8_LDA(At, 0, 1); PG8_STAGE(PG8_SB(0, 0), b2, voffB); PG8_STAGE(PG8_SB(0, 1), b2 + hstep, voffB); PG8_STAGE(PG8_SA(0, 0), a2, voffA);
            PG8_WAIT_V(8); PG8_WAIT_L(0); PG8_BAR; PG8_MMA(1, 0, At, B0); PG8_MMA(1, 1, At, B1); PG8_BAR; PG8_SCHED;
            PG8_LDB(B0, 1, 0); PG8_LDB(B1, 1, 1); PG8_SCHED; PG8_LDA(At, 1, 0); PG8_STAGE(PG8_SA(0, 1), a2 + hstep, voffA);
            PG8_WAIT_V(8); PG8_WAIT_L(0); PG8_BAR; PG8_MMA(0, 0, At, B0); PG8_MMA(0, 1, At, B1); PG8_BAR; PG8_SCHED;
            PG8_LDA(At, 1, 1); PG8_STAGE(PG8_SB(1, 0), b3, voffB); PG8_STAGE(PG8_SB(1, 1), b3 + hstep, voffB); PG8_STAGE(PG8_SA(1, 0), a3, voffA);
            PG8_WAIT_V(8); PG8_WAIT_L(0); PG8_BAR; PG8_MMA(1, 0, At, B0); PG8_MMA(1, 1, At, B1); PG8_BAR; PG8_SCHED;
            } else {
            PG8_LDB(B0, 0, 0); PG8_SCHED; PG8_LDA(At, 0, 0); PG8_STAGE(PG8_SA(1, 1), a1 + hstep, voffA);
            PG8_WAIT_L(8); PG8_BAR; PG8_WAIT_L(0); PG8_MMA(0, 0, At, B0); PG8_BAR; PG8_SCHED;
            PG8_LDB(B1, 0, 1); PG8_STAGE(PG8_SB(0, 0), b2, voffB);
            PG8_BAR; PG8_WAIT_L(0); PG8_MMA(0, 1, At, B1); PG8_BAR;
            PG8_LDA(At, 0, 1); PG8_STAGE(PG8_SA(0, 0), a2, voffA);
            PG8_BAR; PG8_WAIT_L(0); PG8_MMA(1, 0, At, B0); PG8_BAR; PG8_SCHED;
            PG8_STAGE(PG8_SB(0, 1), b2 + hstep, voffB);
            PG8_WAIT_V(6); PG8_BAR; PG8_MMA(1, 1, At, B1); PG8_BAR;
            PG8_LDB(B0, 1, 0); PG8_SCHED; PG8_LDA(At, 1, 0); PG8_STAGE(PG8_SA(0, 1), a2 + hstep, voffA);
            PG8_WAIT_L(8); PG8_BAR; PG8_WAIT_L(0); PG8_MMA(0, 0, At, B0); PG8_BAR; PG8_SCHED;
            PG8_LDB(B1, 1, 1); PG8_STAGE(PG8_SB(1, 0), b3, voffB);
            PG8_BAR; PG8_WAIT_L(0); PG8_MMA(0, 1, At, B1); PG8_BAR;
            PG8_LDA(At, 1, 1); PG8_STAGE(PG8_SA(1, 0), a3, voffA);
            PG8_BAR; PG8_WAIT_L(0); PG8_MMA(1, 0, At, B0); PG8_BAR; PG8_SCHED;
            PG8_STAGE(PG8_SB(1, 1), b3 + hstep, voffB);
            PG8_WAIT_V(6); PG8_BAR; PG8_MMA(1, 1, At, B1); PG8_BAR;
            }
        }
        if constexpr (ALIGN_EPI) { if (wr == 0) PG8_BAR; }
        if constexpr (!Epi::AFTER_DRAIN) { E(acc, cur, wr, wc, fr, fq); S.done(cur); }
        if (!has_next) break;
#pragma unroll
        for (int a = 0; a < 2; ++a)
#pragma unroll
            for (int b = 0; b < 2; ++b)
#pragma unroll
                for (int m = 0; m < 4; ++m)
#pragma unroll
                    for (int n = 0; n < 2; ++n) acc[a][b][m][n] = (f32x4){0.f, 0.f, 0.f, 0.f};
        cur = nxt; cA = nA; cB = nB; ++ui;
        if constexpr (ALIGN_EPI) { if (wr == 1) PG8_BAR; }
    }
    PG8_WAIT_V(0);
    if constexpr (!ALIGN_EPI) { if (wr == 0) PG8_BAR; }
    PG8_BAR;
    if constexpr (Epi::AFTER_DRAIN) { E.fused(acc, cur, wr, wc, fr, fq, lds, wid, lane); S.done(cur); }
#undef PG8_SA
#undef PG8_SB
#undef PG8_STAGE
#undef PG8_LDA
#undef PG8_LDB
#undef PG8_MMA
#undef PG8_WAIT_V
#undef PG8_WAIT_L
#undef PG8_BAR
#undef PG8_SCHED
}
}
namespace pg8 {
struct EpiF32 {
    static constexpr bool PERM = false, AFTER_DRAIN = false;
    float* C; int ldc; const float* bias;
    __device__ __forceinline__ void operator()(const f32x4 (&acc)[2][2][4][2], const Unit& u, int wr, int wc, int fr, int fq) const {
        const int row0 = u.pm * BM + wr * 64 + fr, col0 = u.pn * BM + wc * 32 + 4 * fq;
        f32x4 bv[2][2];
#pragma unroll
        for (int bj = 0; bj < 2; ++bj)
#pragma unroll
            for (int n = 0; n < 2; ++n) bv[bj][n] = bias ? *(const f32x4*)(bias + col0 + bj * HALF + n * 16) : (f32x4){0.f, 0.f, 0.f, 0.f};
#pragma unroll
        for (int ai = 0; ai < 2; ++ai)
#pragma unroll
            for (int m = 0; m < 4; ++m) { float* rowp = C + (size_t)(row0 + ai * HALF + m * 16) * ldc + col0;
#pragma unroll
                for (int bj = 0; bj < 2; ++bj)
#pragma unroll
                    for (int n = 0; n < 2; ++n) *(f32x4*)(rowp + bj * HALF + n * 16) = acc[ai][bj][m][n] + bv[bj][n]; }
    }
};
}
#ifndef PG8_SP2
#define PG8_SP2 true
#endif
#ifndef PG8_ALIGN
#define PG8_ALIGN true
#endif
namespace pg8 {
struct EpiProj {
    static constexpr bool PERM = false, AFTER_DRAIN = false;
    float* U; bf16_t* QB; bf16_t* KB; bf16_t* VB; float* kout; float* vout; float* KSUM; const float* ROPE; float qscale;
    typedef unsigned u32x2v __attribute__((ext_vector_type(2)));
    template <bool ISV> __device__ __forceinline__ void plain(const f32x4 (&acc)[2][2][4][2], int row0, int cb, int wc, int fq) const {
#pragma unroll
        for (int ai = 0; ai < 2; ++ai)
#pragma unroll
            for (int m = 0; m < 4; ++m) { const size_t ro = (size_t)(row0 + ai * HALF + m * 16) * 512 + cb + wc * 32 + 4 * fq;
#pragma unroll
                for (int bj = 0; bj < 2; ++bj)
#pragma unroll
                    for (int n = 0; n < 2; ++n) { const f32x4 v = acc[ai][bj][m][n]; const size_t o = ro + bj * HALF + n * 16;
                        if (!ISV) *(f32x4*)(U + o) = v;
                        else { *(f32x4*)(vout + o) = v; u32x2v w; w.x = cvt_pk_bf16(v[0], v[1]); w.y = cvt_pk_bf16(v[2], v[3]); *(u32x2v*)(VB + o) = w; } } }
    }
    template <bool ISK> __device__ __forceinline__ void rope(const f32x4 (&acc)[2][2][4][2], const Unit& u, int row0, int cb, int wr, int wc, int fr, int fq) const {
        f32x4 s1[2], s2[2];
#pragma unroll
        for (int n = 0; n < 2; ++n) { s1[n] = (f32x4){0.f, 0.f, 0.f, 0.f}; s2[n] = (f32x4){0.f, 0.f, 0.f, 0.f}; }
#pragma unroll
        for (int ai = 0; ai < 2; ++ai)
#pragma unroll
            for (int m = 0; m < 4; ++m) { const int row = row0 + ai * HALF + m * 16, t = row & 8191;
#pragma unroll
                for (int n = 0; n < 2; ++n) { const int i0 = 16 * n + 4 * fq; const size_t o1 = (size_t)row * 512 + cb + wc * 64 + i0, o2 = o1 + 32;
                    const f32x4 cs0 = *(const f32x4*)(ROPE + (size_t)(t * 32 + i0) * 2), cs1 = *(const f32x4*)(ROPE + (size_t)(t * 32 + i0) * 2 + 4);
                    const f32x4 c = (f32x4){cs0[0], cs0[2], cs1[0], cs1[2]}, s = (f32x4){cs0[1], cs0[3], cs1[1], cs1[3]};
                    const f32x4 x1 = acc[ai][0][m][n], x2 = acc[ai][1][m][n];
                    const f32x4 y1 = x1 * c - x2 * s, y2 = x2 * c + x1 * s;
                    if (!ISK) { const f32x4 z1 = y1 * qscale, z2 = y2 * qscale; u32x2v w; w.x = cvt_pk_bf16(z1[0], z1[1]); w.y = cvt_pk_bf16(z1[2], z1[3]); *(u32x2v*)(QB + o1) = w;
                        w.x = cvt_pk_bf16(z2[0], z2[1]); w.y = cvt_pk_bf16(z2[2], z2[3]); *(u32x2v*)(QB + o2) = w; }
                    else { *(f32x4*)(kout + o1) = y1; *(f32x4*)(kout + o2) = y2; u32x2v w; w.x = cvt_pk_bf16(y1[0], y1[1]); w.y = cvt_pk_bf16(y1[2], y1[3]); *(u32x2v*)(KB + o1) = w;
                        w.x = cvt_pk_bf16(y2[0], y2[1]); w.y = cvt_pk_bf16(y2[2], y2[3]); *(u32x2v*)(KB + o2) = w; s1[n] += y1; s2[n] += y2; } }
                asm volatile("" ::: "memory"); }
        if (ISK) {
#pragma unroll
            for (int n = 0; n < 2; ++n) {
#pragma unroll
                for (int e = 0; e < 4; ++e) { float a = s1[n][e], b = s2[n][e];
#pragma unroll
                    for (int o = 1; o < 16; o <<= 1) { a += __shfl_xor(a, o); b += __shfl_xor(b, o); }
                    s1[n][e] = a; s2[n][e] = b; }
                if (fr == 0) { float* kp = KSUM + (size_t)(u.pm * 2 + wr) * 512 + cb + wc * 64 + 16 * n + 4 * fq; *(f32x4*)kp = s1[n]; *(f32x4*)(kp + 32) = s2[n]; } }
        }
    }
    __device__ __forceinline__ void operator()(const f32x4 (&acc)[2][2][4][2], const Unit& u, int wr, int wc, int fr, int fq) const {
        asm volatile("" : "+v"(fr), "+v"(fq));
        const int sec = u.pn >> 1, cb = (u.pn & 1) * 256, row0 = u.pm * BM + wr * 64 + fr;
        if (sec == 0) plain<false>(acc, row0, cb, wc, fq);
        else if (sec == 3) plain<true>(acc, row0, cb, wc, fq);
        else if (sec == 1) rope<false>(acc, u, row0, cb, wr, wc, fr, fq);
        else rope<true>(acc, u, row0, cb, wr, wc, fr, fq);
    }
};
}
namespace pg8 {
struct ConvOrder : StaticOrder {
    __device__ static __forceinline__ int row_of(int pm) { const int seq = pm / 33, i = pm - seq * 33; const int st = (i == 0) ? 0 : ((254 * i < 7936) ? 254 * i : 7936); return seq * 8192 + st; }
    __device__ __forceinline__ int a_row(const Unit& u) const { return row_of(u.pm); }
};
__device__ __forceinline__ float dpp_f(float v, const int ctrl_sel) {
    const int iv = __builtin_bit_cast(int, v); int r;
    if (ctrl_sel == 1) r = __builtin_amdgcn_update_dpp(0, iv, 0x111, 0xf, 0xf, true);
    else if (ctrl_sel == 2) r = __builtin_amdgcn_update_dpp(0, iv, 0x112, 0xf, 0xf, true);
    else if (ctrl_sel == 15) r = __builtin_amdgcn_update_dpp(0, iv, 0x10F, 0xf, 0xf, true);
    else r = __builtin_amdgcn_update_dpp(0, iv, 0x10E, 0xf, 0xf, true);
    return __builtin_bit_cast(float, r);
}
struct EpiConv {
    static constexpr bool PERM = false, AFTER_DRAIN = false;
    bf16_t* ACT; const float* conv_w; const float* conv_b; float* cp_out; PG8_LAS float* halo;
    __device__ __forceinline__ void operator()(const f32x4 (&acc)[2][2][4][2], const Unit& u, int wr, int wc, int fr, int fq) const {
        typedef unsigned u32x2v __attribute__((ext_vector_type(2)));
        asm volatile("" : "+v"(fr), "+v"(fq));
        const int seq = u.pm / 33, ti = u.pm - seq * 33; const bool first = (ti == 0); const int arow = ConvOrder::row_of(u.pm);
        const int cpos = wc * 32 + 4 * fq;
        if (fr >= 14) {
#pragma unroll
            for (int ai = 0; ai < 2; ++ai)
#pragma unroll
                for (int bj = 0; bj < 2; ++bj)
#pragma unroll
                    for (int n = 0; n < 2; ++n) *(PG8_LAS f32x4*)(halo + ((2 * ai + wr) * 2 + (fr - 14)) * 256 + 128 * bj + cpos + 16 * n) = acc[ai][bj][3][n];
        }
        asm volatile("s_waitcnt lgkmcnt(0)" ::: "memory"); __builtin_amdgcn_s_barrier(); asm volatile("" ::: "memory");
#pragma unroll
        for (int n = 0; n < 2; ++n) {
            const int ch = u.pn * 128 + cpos + 16 * n;
            const f32x4 w0a = *(const f32x4*)(conv_w + ch), w1a = *(const f32x4*)(conv_w + 5632 + ch), w2a = *(const f32x4*)(conv_w + 2 * 5632 + ch), ba = *(const f32x4*)(conv_b + ch);
            const f32x4 w0g = *(const f32x4*)(conv_w + 2816 + ch), w1g = *(const f32x4*)(conv_w + 5632 + 2816 + ch), w2g = *(const f32x4*)(conv_w + 2 * 5632 + 2816 + ch), bg = *(const f32x4*)(conv_b + 2816 + ch);
#pragma unroll
            for (int ai = 0; ai < 2; ++ai) {
                const int ck = 2 * ai + wr;
                f32x4 pa = (f32x4){0.f, 0.f, 0.f, 0.f}, pg = (f32x4){0.f, 0.f, 0.f, 0.f};
                if (ck > 0 && fr >= 14) { const PG8_LAS float* hp = halo + ((ck - 1) * 2 + (fr - 14)) * 256 + cpos + 16 * n; pa = *(const PG8_LAS f32x4*)hp; pg = *(const PG8_LAS f32x4*)(hp + 128); }
#pragma unroll
                for (int m = 0; m < 4; ++m) {
                    const f32x4 xa = acc[ai][0][m][n], xg = acc[ai][1][m][n];
                    f32x4 ca, cg;
#pragma unroll
                    for (int e = 0; e < 4; ++e) {
                        const float p1a = dpp_f(xa[e], 1) + dpp_f(pa[e], 15), p2a = dpp_f(xa[e], 2) + dpp_f(pa[e], 14);
                        const float p1g = dpp_f(xg[e], 1) + dpp_f(pg[e], 15), p2g = dpp_f(xg[e], 2) + dpp_f(pg[e], 14);
                        ca[e] = ba[e] + w0a[e] * p2a + w1a[e] * p1a + w2a[e] * xa[e];
                        cg[e] = bg[e] + w0g[e] * p2g + w1g[e] * p1g + w2g[e] * xg[e];
                    }
                    f32x4 act;
#pragma unroll
                    for (int e = 0; e < 4; ++e) act[e] = ca[e] * __builtin_amdgcn_rcpf(1.0f + __builtin_amdgcn_exp2f(-1.4426950408889634f * ca[e])) * cg[e];
                    const int tr = 128 * ai + 64 * wr + 16 * m + fr;
                    if (first || tr >= 2) { u32x2v w; w.x = cvt_pk_bf16(act[0], act[1]); w.y = cvt_pk_bf16(act[2], act[3]); *(u32x2v*)(ACT + (size_t)(arow + tr) * 2816 + ch) = w; }
                    pa = xa; pg = xg;
                }
            }
        }
        if (ti == 32 && wr == 1 && fr >= 14) {
#pragma unroll
            for (int bj = 0; bj < 2; ++bj)
#pragma unroll
                for (int n = 0; n < 2; ++n) *(f32x4*)(cp_out + (size_t)(seq * 2 + (fr - 14)) * 5632 + bj * 2816 + u.pn * 128 + cpos + 16 * n) = acc[1][bj][3][n];
        }
    }
};
}
#define GAS __attribute__((address_space(1)))
#define LAS __attribute__((address_space(3)))
typedef unsigned short bf16;
typedef unsigned v4u __attribute__((ext_vector_type(4)));
typedef float f32x4 __attribute__((ext_vector_type(4)));
typedef short bf16x8 __attribute__((ext_vector_type(8)));
typedef GAS unsigned gu32;
typedef GAS unsigned long long gu64;
#define RLX_AGENT __ATOMIC_RELAXED, __HIP_MEMORY_SCOPE_AGENT
#define LDS_WAIT() asm volatile("s_waitcnt lgkmcnt(0)" ::: "memory")
#define VM_WAIT() asm volatile("s_waitcnt vmcnt(0)" ::: "memory")
__device__ __forceinline__ unsigned long long rt() { return __builtin_amdgcn_s_memrealtime(); }
__device__ __forceinline__ unsigned f2bf(float f) { unsigned u = __builtin_bit_cast(unsigned, f); return (u + 0x7fffu + ((u >> 16) & 1u)) >> 16; }
__device__ __forceinline__ unsigned pk2(float lo, float hi) { return f2bf(lo) | (f2bf(hi) << 16); }

#define XB_TMO      128
#define XB_XCNT(j)  (256  + 64 * (j))
#define XB_XSUB(j)  (1280 + 64 * (j))
#define XB_XGEN(j)  (2304 + 64 * (j))
#define XB_TOP      3328
#define XB_TOPGEN   3392
#define XCD_BAR_WORDS 3456
#define XB_SPIN_CAP (1u << 18)

__device__ __forceinline__ unsigned xb_ld(unsigned* p)              { return __hip_atomic_load(p, __ATOMIC_RELAXED, __HIP_MEMORY_SCOPE_AGENT); }
__device__ __forceinline__ unsigned xb_add(unsigned* p, unsigned v) { return __hip_atomic_fetch_add(p, v, __ATOMIC_RELAXED, __HIP_MEMORY_SCOPE_AGENT); }
__device__ __forceinline__ unsigned xb_xcc_id() { return (unsigned)__builtin_amdgcn_s_getreg((3 << 11) | 20) & 0xFu; }
#define XB_SPIN(cond, bar) do { unsigned _sp = 0; while (cond) { __builtin_amdgcn_s_sleep(1); \
    if ((++_sp & 255u) == 0u) { if (xb_ld(&(bar)[XB_TMO])) break; if (_sp > XB_SPIN_CAP) { atomicAdd(&(bar)[XB_TMO], 1u); break; } } } } while (0)

struct XcdBarrier {
    unsigned* bar; unsigned x;
    volatile LAS unsigned* st;
};

__device__ __forceinline__ XcdBarrier xcd_barrier_post(unsigned* bar, volatile LAS unsigned* st) {
    XcdBarrier b; b.bar = bar; b.x = xb_xcc_id(); b.st = st;
    if (threadIdx.x == 0) (void)xb_add(&bar[XB_XCNT(b.x)], 1u);
    return b;
}
__device__ __forceinline__ void xcd_barrier_complete(unsigned* bar, unsigned x, unsigned& nloc, unsigned& nx) {
    const unsigned G = gridDim.x * gridDim.y * gridDim.z;
    unsigned sum, cnt, mine, sp = 0u;
    for (;;) {
        sum = 0u; cnt = 0u; mine = 0u;
#pragma unroll
        for (unsigned j = 0; j < 16; ++j) { const unsigned c = xb_ld(&bar[XB_XCNT(j)]); sum += c; cnt += (c > 0u) ? 1u : 0u; mine = (j == x) ? c : mine; }
        if (sum == G) break;
        __builtin_amdgcn_s_sleep(1);
        if ((++sp & 255u) == 0u) { if (xb_ld(&bar[XB_TMO])) break; if (sp > XB_SPIN_CAP) { atomicAdd(&bar[XB_TMO], 1u); break; } }
    }
    nloc = mine > 0u ? mine : 1u; nx = cnt > 0u ? cnt : 1u;
}

__device__ __forceinline__ void xcd_barrier(const XcdBarrier& b) {
    asm volatile("s_waitcnt vmcnt(0)" ::: "memory");
    __syncthreads();
    if (threadIdx.x == 0) {
        unsigned* bar = b.bar;
        __builtin_amdgcn_s_waitcnt(0);
        unsigned nloc = b.st[0], nx = b.st[1];
        if (nloc == 0u) { xcd_barrier_complete(bar, b.x, nloc, nx); b.st[0] = nloc; b.st[1] = nx; }
        const unsigned old = xb_add(&bar[XB_XSUB(b.x)], 1u);
        const unsigned gen = old / nloc;
        if (old + 1u == (gen + 1u) * nloc) {
            __builtin_amdgcn_fence(__ATOMIC_RELEASE, "agent");
            asm volatile("s_waitcnt vmcnt(0)" ::: "memory");
            const unsigned og = xb_add(&bar[XB_TOP], 1u);
            const unsigned tg = og / nx;
            if (og + 1u == (tg + 1u) * nx) xb_add(&bar[XB_TOPGEN], 1u);
            else XB_SPIN(xb_ld(&bar[XB_TOPGEN]) == tg, bar);
            __builtin_amdgcn_fence(__ATOMIC_ACQUIRE, "agent");
            xb_add(&bar[XB_XGEN(b.x)], 1u);
            asm volatile("s_waitcnt vmcnt(0)" ::: "memory");
        } else {
            XB_SPIN(xb_ld(&bar[XB_XGEN(b.x)]) == gen, bar);
            __builtin_amdgcn_fence(__ATOMIC_ACQUIRE, "agent");
            asm volatile("s_waitcnt vmcnt(0)" ::: "memory");
        }
    }
    __syncthreads();
}

namespace mb {
typedef short bf16x8 __attribute__((ext_vector_type(8)));
typedef short s16x4 __attribute__((ext_vector_type(4)));
typedef float f32x16 __attribute__((ext_vector_type(16)));
typedef unsigned u32x4 __attribute__((ext_vector_type(4)));
typedef __attribute__((address_space(3))) const char* lds_cptr;
constexpr float C2 = 0.125f * 1.4426950408889634f;
constexpr int PITCH = 512;
constexpr int L_K = 0, L_V = 32768, L_STG = 65536, STG_W = 8704  , L_MISC = 135168;
constexpr int M_WSF = 0, M_PRE = 2048, M_ROW = 4608, M_SCAL = 4864;
__device__ __forceinline__ int crow(int r, int hi) { return (r & 3) + 8 * (r >> 2) + 4 * hi; }
__device__ __forceinline__ void glds16(const void* gsrc, unsigned lds_dst) { unsigned keep;
    asm volatile("s_mov_b32 %0, m0\n\ts_mov_b32 m0, %2\n\ts_nop 0\n\tglobal_load_lds_dwordx4 %1, off\n\ts_mov_b32 m0, %0" : "=&s"(keep) : "v"(gsrc), "s"(lds_dst) : "memory"); }
typedef float f32x2_t __attribute__((ext_vector_type(2))); typedef __bf16 bf16x2_t __attribute__((ext_vector_type(2)));
__device__ __forceinline__ unsigned cvtpk_s(float lo, float hi) { f32x2_t v = {lo, hi}; bf16x2_t b = __builtin_convertvector(v, bf16x2_t); return __builtin_bit_cast(unsigned, b); }

__device__ __forceinline__ void stage_kv(const bf16* KB, const bf16* VB, size_t krow0, int hcol, unsigned lds0, int wid, int lane) {
    const bf16* ksrc = KB + (krow0 + lane) * PITCH + hcol + wid * 8;
    const bf16* vsrc = VB + (krow0 + 16 * (wid & 3) + (lane >> 2)) * PITCH + hcol + (wid >> 2) * 32 + (lane & 3) * 8;
#pragma unroll
    for (int j = 0; j < 4; ++j) {
        glds16(ksrc + (size_t)j * 64 * PITCH, (unsigned)__builtin_amdgcn_readfirstlane(lds0 + L_K + j * 8192 + wid * 1024));
        glds16(vsrc + (size_t)j * 64 * PITCH, (unsigned)__builtin_amdgcn_readfirstlane(lds0 + L_V + j * 8192 + wid * 1024));
    }
}
__device__ __forceinline__ void qkt(f32x16& p0, f32x16& p1, lds_cptr Kslot, const bf16x8 (&qr)[4], int r32, int hi) {
    const lds_cptr kb = Kslot + hi * 1024 + r32 * 16;
    const f32x16 z = {};
#pragma unroll
    for (int d0 = 0; d0 < 4; ++d0) {
        const bf16x8 b0 = *(const __attribute__((address_space(3))) bf16x8*)(kb + d0 * 2048);
        const bf16x8 b1 = *(const __attribute__((address_space(3))) bf16x8*)(kb + d0 * 2048 + 512);
        if (d0 == 0) { p0 = __builtin_amdgcn_mfma_f32_32x32x16_bf16(b0, qr[0], z, 0, 0, 0); p1 = __builtin_amdgcn_mfma_f32_32x32x16_bf16(b1, qr[0], z, 0, 0, 0); }
        else { p0 = __builtin_amdgcn_mfma_f32_32x32x16_bf16(b0, qr[d0], p0, 0, 0, 0); p1 = __builtin_amdgcn_mfma_f32_32x32x16_bf16(b1, qr[d0], p1, 0, 0, 0); }
    }
}
__device__ __forceinline__ void pv(f32x16 (&o)[2], int vb, bf16x8 pa0, bf16x8 pa1, bf16x8 pa2, bf16x8 pa3) {
#pragma unroll
    for (int d0 = 0; d0 < 2; ++d0) { s16x4 lo[4], hi[4];
#pragma unroll
        for (int ks = 0; ks < 4; ++ks) {
            asm volatile("ds_read_b64_tr_b16 %0,%1 offset:%c2" : "=&v"(lo[ks]) : "v"(vb), "i"(d0 * 4096 + ks * 1024) : "memory");
            asm volatile("ds_read_b64_tr_b16 %0,%1 offset:%c2" : "=&v"(hi[ks]) : "v"(vb), "i"(d0 * 4096 + ks * 1024 + 512) : "memory"); }
        asm volatile("s_waitcnt lgkmcnt(0)" ::: "memory"); __builtin_amdgcn_sched_barrier(0);
#define MB_PK(k) (bf16x8){lo[k][0], lo[k][1], lo[k][2], lo[k][3], hi[k][0], hi[k][1], hi[k][2], hi[k][3]}
        o[d0] = __builtin_amdgcn_mfma_f32_32x32x16_bf16(pa0, MB_PK(0), o[d0], 0, 0, 0);
        o[d0] = __builtin_amdgcn_mfma_f32_32x32x16_bf16(pa1, MB_PK(1), o[d0], 0, 0, 0);
        o[d0] = __builtin_amdgcn_mfma_f32_32x32x16_bf16(pa2, MB_PK(2), o[d0], 0, 0, 0);
        o[d0] = __builtin_amdgcn_mfma_f32_32x32x16_bf16(pa3, MB_PK(3), o[d0], 0, 0, 0);
#undef MB_PK
    }
}
template <bool CAUSAL> __device__ __forceinline__ void attend256(const bf16x8 (&qr)[4], lds_cptr lds, unsigned lds0, int lane, int qloc, int jmax, float& m_out, float& l_out, f32x16 (&o)[2]) {
    const int r32 = lane & 31, hi = lane >> 5;
    f32x16 p0[4], p1[4];
#pragma unroll
    for (int j = 0; j < 4; ++j) {
        if (!CAUSAL || j <= jmax) {
            qkt(p0[j], p1[j], lds + L_K + j * 8192, qr, r32, hi);
            if (CAUSAL) {
#pragma unroll
                for (int r = 0; r < 16; ++r) { const int kv = 64 * j + crow(r, hi); if (kv > qloc) p0[j][r] = -INFINITY; if (kv + 32 > qloc) p1[j][r] = -INFINITY; }
            }
        } else {
#pragma unroll
            for (int r = 0; r < 16; ++r) { p0[j][r] = -INFINITY; p1[j][r] = -INFINITY; }
        }
    }
    float mx = -INFINITY;
#pragma unroll
    for (int j = 0; j < 4; ++j)
#pragma unroll
        for (int r = 0; r < 16; ++r) mx = fmaxf(mx, fmaxf(p0[j][r], p1[j][r]));
    mx = fmaxf(mx, __shfl_xor(mx, 32));
    float ls = 0.f;
    __builtin_amdgcn_sched_barrier(0);
    u32x4 pw[4][4];
#pragma unroll
    for (int j = 0; j < 4; ++j) {
        if (!CAUSAL || j <= jmax) {
#pragma unroll
            for (int r = 0; r < 16; ++r) { p0[j][r] = __builtin_amdgcn_exp2f(p0[j][r] - mx); p1[j][r] = __builtin_amdgcn_exp2f(p1[j][r] - mx); ls += p0[j][r] + p1[j][r]; }
            pw[j][0] = (u32x4){cvtpk_s(p0[j][0], p0[j][1]), cvtpk_s(p0[j][2], p0[j][3]), cvtpk_s(p0[j][4], p0[j][5]), cvtpk_s(p0[j][6], p0[j][7])};
            pw[j][1] = (u32x4){cvtpk_s(p0[j][8], p0[j][9]), cvtpk_s(p0[j][10], p0[j][11]), cvtpk_s(p0[j][12], p0[j][13]), cvtpk_s(p0[j][14], p0[j][15])};
            pw[j][2] = (u32x4){cvtpk_s(p1[j][0], p1[j][1]), cvtpk_s(p1[j][2], p1[j][3]), cvtpk_s(p1[j][4], p1[j][5]), cvtpk_s(p1[j][6], p1[j][7])};
            pw[j][3] = (u32x4){cvtpk_s(p1[j][8], p1[j][9]), cvtpk_s(p1[j][10], p1[j][11]), cvtpk_s(p1[j][12], p1[j][13]), cvtpk_s(p1[j][14], p1[j][15])};
        } else {
#pragma unroll
            for (int k = 0; k < 4; ++k) pw[j][k] = (u32x4){0u, 0u, 0u, 0u};
        }
    }
    __builtin_amdgcn_sched_barrier(0);
    o[0] = f32x16{}; o[1] = f32x16{};
    const int vb0 = (int)(lds0 + L_V) + ((lane >> 4) & 1) * 32 + (lane & 3) * 8 + (4 * hi + ((lane & 15) >> 2)) * 64;
#pragma unroll
    for (int j = 0; j < 4; ++j) {
        if (!CAUSAL || j <= jmax)
            pv(o, vb0 + j * 8192, __builtin_bit_cast(bf16x8, pw[j][0]), __builtin_bit_cast(bf16x8, pw[j][1]), __builtin_bit_cast(bf16x8, pw[j][2]), __builtin_bit_cast(bf16x8, pw[j][3]));
    }
    ls += __shfl_xor(ls, 32);
    m_out = mx; l_out = ls;
}
__device__ __forceinline__ void stage_o(const f32x16 (&o)[2], __attribute__((address_space(3))) float* stg, int lane) {
    const int r32 = lane & 31, hi = lane >> 5;
#pragma unroll
    for (int d0 = 0; d0 < 2; ++d0)
#pragma unroll
        for (int r = 0; r < 16; ++r) stg[crow(r, hi) * 68 + d0 * 32 + r32] = o[d0][r];
}
}

constexpr int D = 1024, NB = 2, T = 8192, MP = NB * T, DB = 128, MR = MP + DB  , MT = 16640  ;
constexpr int NH = 8, HD = 64, AW = 512, PW = 512, INW = 2048, FF = 2816, FF2 = 5632;
constexpr int NPAGES = 16, PSTATE = 15, NBLK_P = 32, NBLK_D = 8;
constexpr float RMS_EPS = 1e-6f;
constexpr int NWAVES = 8, NTHREADS = 512;

constexpr size_t O_YP = 0, O_YS = O_YP + (size_t)MP * D, O_KP = O_YS + (size_t)DB * D, O_VP = O_KP + (size_t)MP * AW, O_PP = O_VP + (size_t)MP * AW,
                 O_CP = O_PP + (size_t)NB * PSTATE * PW, O_KS = O_CP + (size_t)NB * 2 * FF2, O_VS = O_KS + (size_t)DB * AW, O_PS = O_VS + (size_t)DB * AW,
                 O_CS = O_PS + (size_t)DB * PSTATE * PW, O_END = O_CS + (size_t)DB * 2 * FF2;
static_assert(O_END == 36279296, "output size");

constexpr size_t MiB = 1u << 20;
constexpr size_t WS_CTL = 0, CTL_ZERO_BYTES = 1 * MiB;
constexpr size_t WS_WIN = 2 * MiB, WS_WO2 = 6 * MiB, WS_WUP = 8 * MiB, WS_WDN = 19 * MiB, WS_MOD = 25 * MiB, WS_ROPE = 29 * MiB, WS_KMD = 31 * MiB, WS_KMP = 33 * MiB;
constexpr size_t WS_XN = 34 * MiB, WS_PROJ = 67 * MiB, WS_QF = 197 * MiB, WS_A2 = 230 * MiB, WS_MIX = 263 * MiB, WS_X1 = 328 * MiB, WS_UP = 393 * MiB, WS_ACT = 751 * MiB, WS_FFN = 841 * MiB, WS_QB = 906 * MiB, WS_KB = 923 * MiB, WS_VB = 940 * MiB, WS_LIST = 957 * MiB, WS_COUNT = 965 * MiB, WS_PO = 966 * MiB, WS_PM = 1016 * MiB, WS_A2REF = 1020 * MiB, WS_U = 1037 * MiB, WS_KSUM = 1070 * MiB, WS_DPO = 1071 * MiB, WS_DPM = 1073 * MiB, WS_END = 1074 * MiB;
static_assert(WS_WIN + (size_t)INW * D * 2 <= WS_WO2 && WS_WO2 + (size_t)D * D * 2 <= WS_WUP && WS_WUP + (size_t)FF2 * D * 2 <= WS_WDN && WS_WDN + (size_t)D * FF * 2 <= WS_MOD, "ws map 1");
static_assert(WS_MOD + (size_t)130 * 6 * D * 4 <= WS_ROPE && WS_ROPE + (size_t)T * 32 * 8 <= WS_KMD && WS_KMD + (size_t)DB * NBLK_D * AW * 4 <= WS_KMP && WS_KMP + (size_t)NB * NBLK_P * AW * 4 <= WS_XN, "ws map 2");
static_assert(WS_XN + (size_t)MT * D * 2 <= WS_PROJ && WS_PROJ + (size_t)MT * INW * 4 <= WS_QF && WS_QF + (size_t)MT * AW * 4 <= WS_A2 && WS_A2 + (size_t)MT * D * 2 <= WS_MIX, "ws map 3");
static_assert(WS_QB + (size_t)MT * AW * 2 <= WS_KB && WS_KB + (size_t)MT * AW * 2 <= WS_VB && WS_VB + (size_t)MT * AW * 2 <= WS_LIST && WS_LIST + (size_t)16 * 32 * 32 * 256 * 2 <= WS_COUNT && WS_COUNT + 16 * 32 * 32 * 4 <= WS_PO && WS_PO + (size_t)MP * NH * 3 * 64 * 2 <= WS_PM && WS_PM + (size_t)MP * NH * 3 * 8 <= WS_A2REF && WS_A2REF + (size_t)MP * AW * 2 <= WS_END, "ws map 5");
static_assert(WS_U + (size_t)MP * PW * 4 <= WS_KSUM && WS_KSUM + (size_t)64 * 2 * 512 * 4 <= WS_DPO && WS_DPO + (size_t)DB * NH * 6 * HD * 4 <= WS_DPM && WS_DPM + (size_t)DB * NH * 6 * 8 <= WS_END, "ws map 6");
static_assert(WS_MIX + (size_t)MT * D * 4 <= WS_X1 && WS_X1 + (size_t)MT * D * 4 <= WS_UP && WS_UP + (size_t)MT * FF2 * 4 <= WS_ACT && WS_ACT + (size_t)MT * FF * 2 <= WS_FFN && WS_FFN + (size_t)MT * D * 4 <= WS_END, "ws map 4");
constexpr int CW_BAR = 4096;

constexpr int LDS_BYTES = 147456;
constexpr int LDSCTL_OFF = 146432, MISC_OFF = LDSCTL_OFF;

__device__ const double ROPE_INV[32] = {
1.00000000000000000000e+00, 7.49894209332455874417e-01, 5.62341325190349072827e-01, 4.21696503428582225581e-01, 3.16227766016837941176e-01, 2.37137370566165517349e-01, 1.77827941003892292526e-01, 1.33352143216332402753e-01,
1.00000000000000005551e-01, 7.49894209332455791150e-02, 5.62341325190349114460e-02, 4.21696503428582239459e-02, 3.16227766016837913421e-02, 2.37137370566165538166e-02, 1.77827941003892292526e-02, 1.33352143216332406223e-02,
1.00000000000000002082e-02, 7.49894209332455791150e-03, 5.62341325190349097113e-03, 4.21696503428582291501e-03, 3.16227766016837939442e-03, 2.37137370566165538166e-03, 1.77827941003892275179e-03, 1.33352143216332406223e-03,
1.00000000000000002082e-03, 7.49894209332455856203e-04, 5.62341325190349097113e-04, 4.21696503428582237290e-04, 3.16227766016837939442e-04, 2.37137370566165538166e-04, 1.77827941003892269758e-04, 1.33352143216332395381e-04};

struct Args { const void* in[23]; float* out; unsigned char* ws; int ph_lo, ph_hi; };

struct Ctx {
    LAS unsigned char* lds;
    int tid, lane, wave, gw, NGW, G;
    const float *x_prompt, *x_sample, *c_prompt, *c_sample, *cache_k, *cache_v; const int* page_table; const float *state_pool, *state_conv;
    const float *w_ada, *b_ada, *g_mix_pre, *g_mix_post, *w_in, *pool_w, *pool_scale, *w_out, *g_ffn_pre, *g_ffn_post, *w_up, *conv_w, *conv_b, *w_down;
    float* out;
    bf16 *WIN, *WO2, *WUP, *WDN, *XN, *A2, *ACT, *QB, *KB, *VB, *PO, *A2REF; unsigned short* LIST; int* COUNT; float2* PM; unsigned* ctl; float *U, *KSUM, *DPO; float2* DPM; float *MOD, *KMD, *KMP, *PROJ, *QF, *MIX, *X1, *UP, *FFN; float2* ROPE;
};

__device__ __forceinline__ float wave_sum(float v) {
#pragma unroll
    for (int o = 1; o < 64; o <<= 1) v += __shfl_xor(v, o);
    return v;
}
__device__ __forceinline__ float wave_max(float v) {
#pragma unroll
    for (int o = 1; o < 64; o <<= 1) v = fmaxf(v, __shfl_xor(v, o));
    return v;
}
__device__ __forceinline__ float silu_f(float v) { return v / (1.0f + __expf(-v)); }

__device__ __forceinline__ void dsincos(double a, double& s, double& c) {
    const double k = __builtin_rint(a * 0.63661977236758134308);
    double r = __builtin_fma(-k, 1.57079632679489655800e+00, a);
    r = __builtin_fma(-k, 6.12323399573676603587e-17, r);
    const double r2 = r * r;
    double sp = 1.0 / 6227020800.0;
    sp = sp * r2 - 1.0 / 39916800.0; sp = sp * r2 + 1.0 / 362880.0; sp = sp * r2 - 1.0 / 5040.0; sp = sp * r2 + 1.0 / 120.0; sp = sp * r2 - 1.0 / 6.0;
    const double sn = r + r * r2 * sp;
    double cp = -1.0 / 87178291200.0;
    cp = cp * r2 + 1.0 / 479001600.0; cp = cp * r2 - 1.0 / 3628800.0; cp = cp * r2 + 1.0 / 40320.0; cp = cp * r2 - 1.0 / 720.0; cp = cp * r2 + 1.0 / 24.0; cp = cp * r2 - 0.5;
    const double cn = 1.0 + r2 * cp;
    const int q = ((int)k) & 3;
    s = (q == 0) ? sn : (q == 1) ? cn : (q == 2) ? -sn : -cn;
    c = (q == 0) ? cn : (q == 1) ? -sn : (q == 2) ? -cn : sn;
}

__device__ __forceinline__ void transpose_item(const float* W, int ldw, bf16* WT, int ldt, int koff, int nblk, LAS float* scr, int item, int lane, int permmode = 0) {
    const int kb = item / nblk, nb = item % nblk, k0 = 64 * kb, n0 = 32 * nb;
#pragma unroll 8
    for (int i = 0; i < 32; ++i) { const int kk = 2 * i + (lane >> 5); scr[kk * 33 + (lane & 31)] = W[(size_t)(k0 + kk) * ldw + n0 + (lane & 31)]; }
    LDS_WAIT(); asm volatile("" ::: "memory");
    const int c = lane & 7;
#pragma unroll
    for (int j = 0; j < 4; ++j) { const int n = (lane >> 3) + 8 * j; const LAS float* s = scr + (8 * c) * 33 + n;
        v4u o; o.x = pk2(s[0 * 33], s[1 * 33]); o.y = pk2(s[2 * 33], s[3 * 33]); o.z = pk2(s[4 * 33], s[5 * 33]); o.w = pk2(s[6 * 33], s[7 * 33]);
        int dn = n0 + n;
        if (permmode == 1 && dn >= 512 && dn < 1536) { const int o_ = dn & 255, hh = o_ >> 6, jj = o_ & 63; dn = (dn & ~255) + ((jj < 32) ? hh * 32 + jj : 128 + hh * 32 + (jj - 32)); }
        if (permmode == 2) { const int cc = (dn < FF) ? dn : dn - FF; dn = (cc >> 7) * 256 + (cc & 127) + ((dn < FF) ? 0 : 128); }
        *(GAS v4u*)(WT + (size_t)dn * ldt + koff + k0 + 8 * c) = o; }
    LDS_WAIT(); asm volatile("" ::: "memory");
}

__device__ __forceinline__ void p0_prologue(Ctx& F) {
    {
        LAS float* sl = (LAS float*)F.lds;
        for (int item = blockIdx.x; item < 120; item += F.G) {
            const int nch = item % 12, rg = item / 12;
            __syncthreads();
            for (int e = F.tid; e < 13 * D; e += NTHREADS) { const int rr = e >> 10, k = e & 1023, row = rg * 13 + rr;
                const float cv = (row < 2) ? F.c_prompt[row * D + k] : F.c_sample[(row - 2) * D + k]; sl[e] = silu_f(cv); }
            __syncthreads();
            const int n = nch * 512 + F.tid;
            float acc[13];
#pragma unroll
            for (int rr = 0; rr < 13; ++rr) acc[rr] = 0.f;
            for (int k = 0; k < D; ++k) { const float w = F.w_ada[(size_t)k * (6 * D) + n];
#pragma unroll
                for (int rr = 0; rr < 13; ++rr) acc[rr] += sl[rr * D + k] * w; }
            const float bv = F.b_ada[n];
#pragma unroll
            for (int rr = 0; rr < 13; ++rr) F.MOD[(size_t)(rg * 13 + rr) * (6 * D) + n] = acc[rr] + bv;
        }
        __syncthreads();
    }
    {
        LAS float* scr = (LAS float*)(F.lds + F.wave * 16384);
        constexpr int I_IN = (D / 64) * (INW / 32), I_O = (512 / 64) * (D / 32), I_UP = (D / 64) * (FF2 / 32), I_DN = (FF / 64) * (D / 32);
        constexpr int NITEMS = I_IN + I_O + I_UP + I_DN;
        for (int it = F.gw; it < NITEMS; it += F.NGW) {
            int r = it;
            if (r < I_IN) { transpose_item(F.w_in, INW, F.WIN, D, 0, INW / 32, scr, r, F.lane, 1); continue; } r -= I_IN;
            if (r < I_O) { transpose_item(F.w_out + (size_t)512 * D, D, F.WO2, D, 512, D / 32, scr, r, F.lane); continue; } r -= I_O;
            if (r < I_UP) { transpose_item(F.w_up, FF2, F.WUP, D, 0, FF2 / 32, scr, r, F.lane, 2); continue; } r -= I_UP;
            transpose_item(F.w_down, D, F.WDN, FF, 0, D / 32, scr, r, F.lane);
        }
    }
    for (int it = F.gw; it < D * 8; it += F.NGW) {
        const int n = it >> 3, kch = it & 7, k = kch * 64 + F.lane, g = k >> 7;
        const float* pw = F.pool_w + (size_t)k * 128;
        float acc = 0.f;
        for (int d = 0; d < 128; ++d) acc += pw[d] * (F.pool_scale[g * 128 + d] * F.w_out[(size_t)(g * 128 + d) * D + n]);
        F.WO2[(size_t)n * D + k] = (bf16)f2bf(acc);
    }
    for (int e = blockIdx.x * NTHREADS + F.tid; e < T * 32; e += F.G * NTHREADS) {
        const int pos = e >> 5, i = e & 31; double s, c; dsincos((double)pos * ROPE_INV[i], s, c);
        F.ROPE[e] = make_float2((float)c, (float)s);
    }
    {
        LAS f32x4* red = (LAS f32x4*)F.lds;
        const int ts = F.tid >> 7, c4 = F.tid & 127;
        for (int item = blockIdx.x; item < DB * NBLK_D; item += F.G) {
            const int b = item >> 3, n = item & 7;
            const int pg0 = F.page_table[b * NPAGES + 2 * n], pg1 = F.page_table[b * NPAGES + 2 * n + 1];
            f32x4 acc = (f32x4){0.f, 0.f, 0.f, 0.f};
#pragma unroll 8
            for (int itk = 0; itk < 64; ++itk) { const int tok = itk * 4 + ts; const int pg = (tok < 128) ? pg0 : pg1;
                acc += *(const f32x4*)(F.cache_k + ((size_t)pg * 128 + (tok & 127)) * AW + c4 * 4); }
            __syncthreads();
            red[ts * 128 + c4] = acc;
            __syncthreads();
            if (F.tid < 128) { const f32x4 s = (red[c4] + red[128 + c4]) + (red[256 + c4] + red[384 + c4]);
                *(f32x4*)(F.KMD + (size_t)item * AW + c4 * 4) = s * (1.0f / 256.0f); }
        }
        __syncthreads();
    }
}

__device__ __forceinline__ const float* x_row(const Ctx& F, int r) { return (r < MP) ? F.x_prompt + (size_t)r * D : F.x_sample + (size_t)(r - MP) * D; }
__device__ __forceinline__ int mod_row(int r) { return (r < MP) ? (r >> 13) : 2 + (r - MP); }

__device__ __forceinline__ void p1_norm_in(Ctx& F) {
    for (int r = F.gw; r < MT; r += F.NGW) {
        GAS unsigned long long* o8 = (GAS unsigned long long*)(F.XN + (size_t)r * D) + F.lane;
        if (r >= MR) {
#pragma unroll
            for (int j = 0; j < 4; ++j) o8[64 * j] = 0ull;
            GAS unsigned long long* a8 = (GAS unsigned long long*)(F.A2 + (size_t)r * D) + F.lane;
#pragma unroll
            for (int j = 0; j < 4; ++j) a8[64 * j] = 0ull;
            GAS unsigned long long* c8 = (GAS unsigned long long*)(F.ACT + (size_t)r * FF) + F.lane;
            for (int j = 0; j < FF / 256; ++j) c8[64 * j] = 0ull;
            continue;
        }
        const f32x4* xr = (const f32x4*)x_row(F, r) + F.lane;
        const float* mod = F.MOD + (size_t)mod_row(r) * (6 * D);
        f32x4 v[4]; float ss = 0.f;
#pragma unroll
        for (int j = 0; j < 4; ++j) { v[j] = xr[64 * j]; ss += (v[j].x * v[j].x + v[j].y * v[j].y) + (v[j].z * v[j].z + v[j].w * v[j].w); }
        const float rs = 1.0f / sqrtf(wave_sum(ss) * (1.0f / D) + RMS_EPS);
#pragma unroll
        for (int j = 0; j < 4; ++j) { const int c = 4 * F.lane + 256 * j;
            const f32x4 g = *(const f32x4*)(F.g_mix_pre + c), sh = *(const f32x4*)(mod + c), sc = *(const f32x4*)(mod + D + c);
            const f32x4 h = v[j] * rs * g * (sc + 1.0f) + sh;
            o8[64 * j] = (unsigned long long)pk2(h.x, h.y) | ((unsigned long long)pk2(h.z, h.w) << 32); }
    }
}

__device__ __forceinline__ void p3_post_proj(Ctx& F) {
    for (int r = MP + F.gw; r < MR; r += F.NGW) {
        const bool dec = r >= MP; const int bb = dec ? (r - MP) : (r >> 13), t = dec ? 0 : (r & (T - 1)), pos = dec ? 2048 : t;
        const float* P = F.PROJ + (size_t)r * INW;
        float* kout = dec ? F.out + O_KS + (size_t)bb * AW : F.out + O_KP + (size_t)r * AW;
        float* vout = dec ? F.out + O_VS + (size_t)bb * AW : F.out + O_VP + (size_t)r * AW;
        float* qout = F.QF + (size_t)r * AW;
#pragma unroll
        for (int j = 0; j < 4; ++j) { const int pi = F.lane + 64 * j, hh = pi >> 5, i = pi & 31, col = hh * 64 + i;
            const float2 cs = F.ROPE[pos * 32 + i];
            const int pcol = (hh >> 2) * 256 + (hh & 3) * 32 + i;
            const float q1 = P[512 + pcol], q2 = P[512 + pcol + 128], k1 = P[1024 + pcol], k2 = P[1024 + pcol + 128];
            const float qa = q1 * cs.x - q2 * cs.y, qb = q2 * cs.x + q1 * cs.y, ka = k1 * cs.x - k2 * cs.y, kb = k2 * cs.x + k1 * cs.y;
            qout[col] = qa; qout[col + 32] = qb; kout[col] = ka; kout[col + 32] = kb;
            F.QB[(size_t)r * AW + col] = (bf16)f2bf(qa * mb::C2); F.QB[(size_t)r * AW + col + 32] = (bf16)f2bf(qb * mb::C2);
            F.KB[(size_t)r * AW + col] = (bf16)f2bf(ka); F.KB[(size_t)r * AW + col + 32] = (bf16)f2bf(kb); }
#pragma unroll
        for (int j = 0; j < 2; ++j) { const f32x4 vv = *(const f32x4*)(P + 1536 + (F.lane + 64 * j) * 4); *(f32x4*)(vout + (F.lane + 64 * j) * 4) = vv;
            *(GAS unsigned long long*)(F.VB + (size_t)r * AW + (F.lane + 64 * j) * 4) = (unsigned long long)pk2(vv.x, vv.y) | ((unsigned long long)pk2(vv.z, vv.w) << 32); }
        const int c = F.lane * 8, g = c >> 7, w = 2 << g;
        const f32x4 u0 = *(const f32x4*)(P + c), u1 = *(const f32x4*)(P + c + 4);
        f32x4 s0 = u0, s1 = u1; int nterms;
        if (!dec) {
            nterms = (t + 1 < w) ? t + 1 : w;
            for (int s = 1; s < 16; ++s) if (s < nterms) { const float* pp = P - (size_t)s * INW + c; s0 += *(const f32x4*)pp; s1 += *(const f32x4*)(pp + 4); }
            if (t >= T - PSTATE) { float* po = F.out + O_PP + ((size_t)bb * PSTATE + (t - (T - PSTATE))) * PW + c; *(f32x4*)po = u0; *(f32x4*)(po + 4) = u1; }
        } else {
            nterms = w;
            const float* sp = F.state_pool + (size_t)bb * PSTATE * PW + c;
            for (int s = 1; s < 16; ++s) if (s < w) { const float* pp = sp + (size_t)(PSTATE - s) * PW; s0 += *(const f32x4*)pp; s1 += *(const f32x4*)(pp + 4); }
            float* po = F.out + O_PS + (size_t)bb * PSTATE * PW + c;
            for (int j = 0; j < PSTATE - 1; ++j) { *(f32x4*)(po + (size_t)j * PW) = *(const f32x4*)(sp + (size_t)(j + 1) * PW); *(f32x4*)(po + (size_t)j * PW + 4) = *(const f32x4*)(sp + (size_t)(j + 1) * PW + 4); }
            *(f32x4*)(po + (size_t)(PSTATE - 1) * PW) = u0; *(f32x4*)(po + (size_t)(PSTATE - 1) * PW + 4) = u1;
        }
        const float inv = 1.0f / (float)nterms;
        const f32x4 p0 = s0 * inv - u0, p1 = s1 * inv - u1;
        v4u o; o.x = pk2(p0.x, p0.y); o.y = pk2(p0.z, p0.w); o.z = pk2(p1.x, p1.y); o.w = pk2(p1.z, p1.w);
        *(GAS v4u*)(F.A2 + (size_t)r * D + c) = o;
    }
}


__device__ __forceinline__ void p3_pool_prompt(Ctx& F) {
    for (int r = F.gw; r < MP; r += F.NGW) {
        const int bb = r >> 13, t = r & (T - 1);
        const float* P = F.U + (size_t)r * PW;
        const int c = F.lane * 8, g = c >> 7, w = 2 << g;
        const f32x4 u0 = *(const f32x4*)(P + c), u1 = *(const f32x4*)(P + c + 4);
        f32x4 s0 = u0, s1 = u1;
        const int nterms = (t + 1 < w) ? t + 1 : w;
        for (int s = 1; s < 16; ++s) if (s < nterms) { const float* pp = P - (size_t)s * PW + c; s0 += *(const f32x4*)pp; s1 += *(const f32x4*)(pp + 4); }
        if (t >= T - PSTATE) { float* po = F.out + O_PP + ((size_t)bb * PSTATE + (t - (T - PSTATE))) * PW + c; *(f32x4*)po = u0; *(f32x4*)(po + 4) = u1; }
        const float inv = 1.0f / (float)nterms;
        const f32x4 p0 = s0 * inv - u0, p1 = s1 * inv - u1;
        v4u o; o.x = pk2(p0.x, p0.y); o.y = pk2(p0.z, p0.w); o.z = pk2(p1.x, p1.y); o.w = pk2(p1.z, p1.w);
        *(GAS v4u*)(F.A2 + (size_t)r * D + c) = o;
    }
}

template <bool PROMPT_REF> __device__ __forceinline__ void p4_attention_naive(Ctx& F) {
    LAS float* qs = (LAS float*)(F.lds + F.wave * 8192);
    LAS float* S = qs + 64;
    const float* Kf = F.out + O_KP; const float* Vf = F.out + O_VP;
    const int I0 = PROMPT_REF ? 0 : MP * NH, NITEM = PROMPT_REF ? MP * NH : MP * NH + DB * NH;
    for (int idx = I0 + F.gw; idx < NITEM; idx += F.NGW) {
        const bool dec = idx >= MP * NH;
        const int r = dec ? MP + ((idx - MP * NH) >> 3) : (idx >> 3), hh = idx & 7;
        const int bb = dec ? (r - MP) : (r >> 13), t = dec ? 2048 : (r & (T - 1)), own = t >> 8;
        LDS_WAIT(); asm volatile("" ::: "memory");
        qs[F.lane] = F.QF[(size_t)r * AW + hh * HD + F.lane];
        LDS_WAIT(); asm volatile("" ::: "memory");
        float gate = -INFINITY;
        if (F.lane < own) {
            const float* km = dec ? F.KMD + ((size_t)bb * NBLK_D + F.lane) * AW + hh * HD : F.KMP + ((size_t)bb * NBLK_P + F.lane) * AW + hh * HD;
            float acc = 0.f;
            for (int d = 0; d < HD; ++d) acc += qs[d] * km[d];
            gate = acc;
        }
        int sel0 = 0, sel1 = 0, sel2 = 0, nsel = 0;
#pragma unroll
        for (int k = 0; k < 3; ++k) {
            const float m = wave_max(gate);
            if (m != -INFINITY) {
                const unsigned long long bal = __ballot(gate == m);
                const int ix = __ffsll((long long)bal) - 1;
                if (k == 0) sel0 = ix; else if (k == 1) sel1 = ix; else sel2 = ix;
                nsel = k + 1;
                if (F.lane == ix) gate = -INFINITY;
            }
        }
        const int nblk = nsel + 1;
        float lmax = -INFINITY;
        for (int j = 0; j < nblk; ++j) {
            const int blk = (j < nsel) ? ((j == 0) ? sel0 : (j == 1) ? sel1 : sel2) : own;
            if (dec && j == nsel) {
                const float* kp = F.out + O_KS + (size_t)bb * AW + hh * HD;
                float acc = 0.f;
                for (int d = 0; d < HD; ++d) acc += qs[d] * kp[d];
                const float s = acc * 0.125f;
                if (F.lane == 0) S[j * 256] = s;
                lmax = fmaxf(lmax, s);
                continue;
            }
            for (int rr = 0; rr < 4; ++rr) {
                const int kk = rr * 64 + F.lane, key = blk * 256 + kk;
                const float* kp;
                if (dec) { const int pg = F.page_table[bb * NPAGES + 2 * blk + (kk >> 7)]; kp = F.cache_k + ((size_t)pg * 128 + (kk & 127)) * AW + hh * HD; }
                else kp = Kf + ((size_t)bb * T + key) * AW + hh * HD;
                float acc = 0.f;
#pragma unroll
                for (int d4 = 0; d4 < 16; ++d4) { const f32x4 kv = *(const f32x4*)(kp + 4 * d4); const f32x4 qv = *(const LAS f32x4*)(qs + 4 * d4);
                    acc += (kv.x * qv.x + kv.y * qv.y) + (kv.z * qv.z + kv.w * qv.w); }
                float s = acc * 0.125f;
                if (key > t) s = -INFINITY;
                S[j * 256 + kk] = s;
                lmax = fmaxf(lmax, s);
            }
        }
        const float m = wave_max(lmax);
        LDS_WAIT(); asm volatile("" ::: "memory");
        const int nkeys = (dec ? nsel * 256 + 1 : nblk * 256);
        float lsum = 0.f;
        for (int e = F.lane; e < nkeys; e += 64) { const float p = __expf(S[e] - m); S[e] = p; lsum += p; }
        const float l = wave_sum(lsum);
        LDS_WAIT(); asm volatile("" ::: "memory");
        float acc = 0.f;
        for (int j = 0; j < nblk; ++j) {
            const int blk = (j < nsel) ? ((j == 0) ? sel0 : (j == 1) ? sel1 : sel2) : own;
            if (dec && j == nsel) { acc += S[j * 256] * F.out[O_VS + (size_t)bb * AW + hh * HD + F.lane]; continue; }
            int kend = 256;
            if (!dec && j == nsel) kend = t - own * 256 + 1;
            if (dec) {
                const int pg0 = F.page_table[bb * NPAGES + 2 * blk], pg1 = F.page_table[bb * NPAGES + 2 * blk + 1];
                for (int kk = 0; kk < 256; ++kk) { const int pg = (kk < 128) ? pg0 : pg1;
                    acc += S[j * 256 + kk] * F.cache_v[((size_t)pg * 128 + (kk & 127)) * AW + hh * HD + F.lane]; }
            } else {
                const float* vp = Vf + ((size_t)bb * T + blk * 256) * AW + hh * HD + F.lane;
                for (int kk = 0; kk < kend; ++kk) acc += S[j * 256 + kk] * vp[(size_t)kk * AW];
            }
        }
        if (PROMPT_REF) F.A2REF[(size_t)r * AW + hh * HD + F.lane] = (bf16)f2bf(acc / l);
        else F.A2[(size_t)r * D + 512 + hh * HD + F.lane] = (bf16)f2bf(acc / l);
    }
}

__device__ __forceinline__ void p6_mid_norm(Ctx& F) {
    for (int r = F.gw; r < MR; r += F.NGW) {
        const f32x4* xr = (const f32x4*)x_row(F, r) + F.lane;
        const f32x4* mr = (const f32x4*)(F.MIX + (size_t)r * D) + F.lane;
        const float* mod = F.MOD + (size_t)mod_row(r) * (6 * D);
        f32x4 v[4]; float ss = 0.f;
#pragma unroll
        for (int j = 0; j < 4; ++j) { v[j] = mr[64 * j]; ss += (v[j].x * v[j].x + v[j].y * v[j].y) + (v[j].z * v[j].z + v[j].w * v[j].w); }
        const float rs = 1.0f / sqrtf(wave_sum(ss) * (1.0f / D) + RMS_EPS);
        float ss2 = 0.f;
#pragma unroll
        for (int j = 0; j < 4; ++j) { const int c = 4 * F.lane + 256 * j;
            const f32x4 g = *(const f32x4*)(F.g_mix_post + c), gt = *(const f32x4*)(mod + 2 * D + c);
            v[j] = xr[64 * j] + gt * (v[j] * rs * g);
            *((f32x4*)(F.X1 + (size_t)r * D) + F.lane + 64 * j) = v[j];
            ss2 += (v[j].x * v[j].x + v[j].y * v[j].y) + (v[j].z * v[j].z + v[j].w * v[j].w); }
        const float rs2 = 1.0f / sqrtf(wave_sum(ss2) * (1.0f / D) + RMS_EPS);
        GAS unsigned long long* o8 = (GAS unsigned long long*)(F.XN + (size_t)r * D) + F.lane;
#pragma unroll
        for (int j = 0; j < 4; ++j) { const int c = 4 * F.lane + 256 * j;
            const f32x4 g = *(const f32x4*)(F.g_ffn_pre + c), sh = *(const f32x4*)(mod + 3 * D + c), sc = *(const f32x4*)(mod + 4 * D + c);
            const f32x4 h = v[j] * rs2 * g * (sc + 1.0f) + sh;
            o8[64 * j] = (unsigned long long)pk2(h.x, h.y) | ((unsigned long long)pk2(h.z, h.w) << 32); }
    }
}

__device__ __forceinline__ void p8_conv_act(Ctx& F) {
    for (int r = MP + blockIdx.x; r < MR; r += F.G) {
        const bool dec = r >= MP; const int bb = dec ? (r - MP) : (r >> 13), t = dec ? 0 : (r & (T - 1));
        const float* u2 = F.UP + (size_t)r * FF2;
        const float* u1; const float* u0; bool z1 = false, z0 = false;
        if (dec) { u0 = F.state_conv + (size_t)bb * 2 * FF2; u1 = u0 + FF2; }
        else { u1 = u2 - FF2; u0 = u2 - 2 * (size_t)FF2; z1 = (t < 1); z0 = (t < 2); }
        for (int j = F.tid; j < FF; j += NTHREADS) {
            const int pj = (j >> 7) * 256 + (j & 127);
            const float a2 = u2[pj], g2 = u2[pj + 128];
            const float a1 = z1 ? 0.f : u1[j], g1 = z1 ? 0.f : u1[j + FF];
            const float a0 = z0 ? 0.f : u0[j], g0 = z0 ? 0.f : u0[j + FF];
            const float ca = F.conv_b[j] + F.conv_w[j] * a0 + F.conv_w[FF2 + j] * a1 + F.conv_w[2 * FF2 + j] * a2;
            const float cg = F.conv_b[j + FF] + F.conv_w[j + FF] * g0 + F.conv_w[FF2 + j + FF] * g1 + F.conv_w[2 * FF2 + j + FF] * g2;
            F.ACT[(size_t)r * FF + j] = (bf16)f2bf(silu_f(ca) * cg);
            if (dec) { float* o = F.out + O_CS + (size_t)bb * 2 * FF2; o[j] = a1; o[j + FF] = g1; o[FF2 + j] = a2; o[FF2 + j + FF] = g2; }
            else if (t >= T - 2) { float* o = F.out + O_CP + ((size_t)bb * 2 + (t - (T - 2))) * FF2; o[j] = a2; o[j + FF] = g2; }
        }
    }
}

__device__ __forceinline__ void p10_final(Ctx& F) {
    for (int r = F.gw; r < MR; r += F.NGW) {
        const f32x4* fr = (const f32x4*)(F.FFN + (size_t)r * D) + F.lane;
        const f32x4* x1 = (const f32x4*)(F.X1 + (size_t)r * D) + F.lane;
        const float* mod = F.MOD + (size_t)mod_row(r) * (6 * D);
        float* yo = (r < MP) ? F.out + O_YP + (size_t)r * D : F.out + O_YS + (size_t)(r - MP) * D;
        f32x4 v[4]; float ss = 0.f;
#pragma unroll
        for (int j = 0; j < 4; ++j) { v[j] = fr[64 * j]; ss += (v[j].x * v[j].x + v[j].y * v[j].y) + (v[j].z * v[j].z + v[j].w * v[j].w); }
        const float rs = 1.0f / sqrtf(wave_sum(ss) * (1.0f / D) + RMS_EPS);
#pragma unroll
        for (int j = 0; j < 4; ++j) { const int c = 4 * F.lane + 256 * j;
            const f32x4 g = *(const f32x4*)(F.g_ffn_post + c), gt = *(const f32x4*)(mod + 5 * D + c);
            *((f32x4*)yo + F.lane + 64 * j) = x1[64 * j] + gt * (v[j] * rs * g); }
    }
}


__device__ __forceinline__ void s1a_select(Ctx& F) {
    const int lane = F.lane, wid = F.wave, r32 = lane & 31, hi = lane >> 5;
    LAS unsigned* cnt = (LAS unsigned*)(F.lds);
    LAS unsigned short* lst = (LAS unsigned short*)(F.lds + 128);
    for (int u = blockIdx.x; u < NB * NH * NBLK_P; u += F.G) {
        const int bh = u >> 5, Qb = u & 31, b = bh >> 3, h = bh & 7;
        if (Qb == 0) continue;
        __syncthreads();
        if (F.tid < 32) cnt[F.tid] = 0u;
        const size_t row = (size_t)b * T + Qb * 256 + wid * 32 + r32;
        mb::bf16x8 qr[4];
#pragma unroll
        for (int d0 = 0; d0 < 4; ++d0) qr[d0] = *(const mb::bf16x8*)(F.QB + row * AW + h * HD + 16 * d0 + 8 * hi);
        mb::f32x16 g = {};
#pragma unroll
        for (int d0 = 0; d0 < 4; ++d0) {
            const float* km = F.KSUM + ((size_t)(b * NBLK_P + r32) * 2 * AW + h * HD + 16 * d0 + 8 * hi);
            const f32x4 a = (*(const f32x4*)km + *(const f32x4*)(km + AW)) * (1.0f / 256.0f), c = (*(const f32x4*)(km + 4) + *(const f32x4*)(km + AW + 4)) * (1.0f / 256.0f);
            const float x[8] = {a.x, a.y, a.z, a.w, c.x, c.y, c.z, c.w};
            mb::bf16x8 ah, al;
#pragma unroll
            for (int j = 0; j < 8; ++j) { const unsigned hb = f2bf(x[j]); const float rem = x[j] - __uint_as_float(hb << 16); ah[j] = (short)hb; al[j] = (short)f2bf(rem); }
            g = __builtin_amdgcn_mfma_f32_32x32x16_bf16(ah, qr[d0], g, 0, 0, 0);
            g = __builtin_amdgcn_mfma_f32_32x32x16_bf16(al, qr[d0], g, 0, 0, 0);
        }
        float v[16];
#pragma unroll
        for (int r = 0; r < 16; ++r) v[r] = (mb::crow(r, hi) < Qb) ? g[r] : -INFINITY;
        int sel[3];
#pragma unroll
        for (int k = 0; k < 3; ++k) {
            float bv = -INFINITY; int bi = 64;
#pragma unroll
            for (int r = 0; r < 16; ++r) if (v[r] > bv) { bv = v[r]; bi = mb::crow(r, hi); }
            const float pvv = __shfl_xor(bv, 32); const int pii = __shfl_xor(bi, 32);
            const bool tp = (pvv > bv) || (pvv == bv && pii < bi);
            const float wv = tp ? pvv : bv; const int wi = tp ? pii : bi;
            sel[k] = (wv == -INFINITY) ? -1 : wi;
#pragma unroll
            for (int r = 0; r < 16; ++r) if (mb::crow(r, hi) == wi) v[r] = -INFINITY;
        }
        __syncthreads();
        if (hi == 0) {
#pragma unroll
            for (int k = 0; k < 3; ++k) if (sel[k] >= 0) {
                const unsigned pos = __hip_atomic_fetch_add(cnt + sel[k], 1u, __ATOMIC_RELAXED, __HIP_MEMORY_SCOPE_WORKGROUP);
                lst[sel[k] * 256 + pos] = (unsigned short)((k << 8) | (wid * 32 + r32)); }
        }
        __syncthreads();
        { const int n = F.tid >> 4, part = F.tid & 15;
          if (n < Qb) { const size_t ub = ((size_t)(bh * 32 + n) * 32 + Qb);
              const LAS v4u* src = (const LAS v4u*)(lst + n * 256 + part * 16); GAS v4u* dst = (GAS v4u*)(F.LIST + ub * 256 + part * 16);
              dst[0] = src[0]; dst[1] = src[1];
              if (part == 0) F.COUNT[ub] = (int)cnt[n]; } }
    }
    __syncthreads();
}

__device__ __forceinline__ void s2_past(Ctx& F) {
    int lane = F.lane; const int wid = F.wave; int r32 = lane & 31, hi = lane >> 5;
    LAS unsigned char* misc = F.lds + mb::L_MISC;
    LAS int* PRE = (LAS int*)(misc + mb::M_PRE);
    LAS int* ROW = (LAS int*)(misc + mb::M_ROW);
    LAS int* WT = (LAS int*)(misc + mb::M_SCAL);
    const unsigned lds0 = (unsigned)(uintptr_t)F.lds;
    const mb::lds_cptr ldsc = (mb::lds_cptr)F.lds;
    {
        const int u = F.tid, n = u & 31; int L = 0; const int* cp = F.COUNT + (size_t)u * 32;
        for (int q = 0; q < 32; ++q) if (q > n) L += cp[q];
        int x = (L + 255) >> 8;
#pragma unroll
        for (int o = 1; o < 64; o <<= 1) { const int y = __shfl_up(x, o); if (lane >= o) x += y; }
        __syncthreads();
        if (lane == 63) WT[wid] = x;
        __syncthreads();
        int base = 0;
#pragma unroll
        for (int w = 0; w < 8; ++w) if (w < wid) base += WT[w];
        PRE[u + 1] = base + x; if (u == 0) PRE[0] = 0;
        __syncthreads();
    }
    const int NI = PRE[512];
    const int i0 = (int)((long long)NI * blockIdx.x / F.G), i1 = (int)((long long)NI * (blockIdx.x + 1) / F.G);
    int cur = -1;
    for (int it = i0; it < i1; ++it) {
        asm volatile("" : "+v"(lane)); r32 = lane & 31; hi = lane >> 5;
        int lo = 0, hi_ = 512;
        while (hi_ - lo > 1) { const int mid = (lo + hi_) >> 1; if (PRE[mid] <= it) lo = mid; else hi_ = mid; }
        const int u = __builtin_amdgcn_readfirstlane(lo), c = it - PRE[u], bh = u >> 5, n = u & 31, b = bh >> 3, h = bh & 7;
        if (u != cur) {
            __syncthreads();
            mb::stage_kv(F.KB, F.VB, (size_t)b * T + n * 256, h * HD, lds0, wid, lane);
            if (wid == 0) {
                int x = (lane < 32 && lane > n) ? F.COUNT[(size_t)u * 32 + lane] : 0;
#pragma unroll
                for (int o = 1; o < 32; o <<= 1) { const int y = __shfl_up(x, o); if (lane >= o) x += y; }
                if (lane < 32) ROW[lane + 1] = x;
                if (lane == 0) ROW[0] = 0;
            }
            asm volatile("s_waitcnt vmcnt(0) lgkmcnt(0)" ::: "memory");
            __syncthreads();
            cur = u;
        }
        const int Ltot = ROW[32];
        const int e = c * 256 + wid * 32 + r32; const bool valid = e < Ltot; const int ee = valid ? e : c * 256;
        int ql = 0, qh = 32;
#pragma unroll
        for (int s = 0; s < 5; ++s) { const int mid = (ql + qh) >> 1; if (ROW[mid] <= ee) ql = mid; else qh = mid; }
        const int Qb = ql, idx = ee - ROW[Qb];
        const unsigned ent = F.LIST[((size_t)u * 32 + Qb) * 256 + idx];
        const int slot = (int)(ent >> 8), tl = (int)(ent & 255u);
        const size_t row = (size_t)b * T + Qb * 256 + tl;
        mb::bf16x8 qr[4];
#pragma unroll
        for (int d0 = 0; d0 < 4; ++d0) qr[d0] = *(const mb::bf16x8*)(F.QB + row * AW + h * HD + 16 * d0 + 8 * hi);
        float m, l; mb::f32x16 o[2];
        mb::attend256<false>(qr, ldsc, lds0, lane, 0, 3, m, l, o);
        const int pidx = valid ? (int)((row * NH + h) * 3 + slot) : -1;
        if (valid && hi == 0) F.PM[pidx] = make_float2(m, l);
        LAS float* stg = (LAS float*)(F.lds + mb::L_STG + wid * mb::STG_W);
        mb::stage_o(o, stg, lane);
        LDS_WAIT(); asm volatile("" ::: "memory");
#pragma unroll
        for (int i = 0; i < 4; ++i) { const int q = i * 8 + (lane >> 3), ch = lane & 7; const int pq = __shfl(pidx, q);
            if (pq >= 0) { const f32x4 a0 = *(const LAS f32x4*)(stg + q * 68 + ch * 8), a1 = *(const LAS f32x4*)(stg + q * 68 + ch * 8 + 4);
                v4u w; w.x = pk2(a0.x, a0.y); w.y = pk2(a0.z, a0.w); w.z = pk2(a1.x, a1.y); w.w = pk2(a1.z, a1.w);
                *(GAS v4u*)(F.PO + (size_t)pq * 64 + ch * 8) = w; } }
        LDS_WAIT(); asm volatile("" ::: "memory");
    }
    __syncthreads();
}

__device__ __forceinline__ void s1b_own_merge(Ctx& F) {
    const int lane = F.lane, wid = F.wave, r32 = lane & 31, hi = lane >> 5;
    const unsigned lds0 = (unsigned)(uintptr_t)F.lds;
    const mb::lds_cptr ldsc = (mb::lds_cptr)F.lds;
    LAS float* wsf = (LAS float*)(F.lds + mb::L_MISC + mb::M_WSF) + wid * 64;
    LAS float* stg = (LAS float*)(F.lds + mb::L_STG + wid * mb::STG_W);
    for (int u = blockIdx.x; u < NB * NH * NBLK_P; u += F.G) {
        const int bh = u >> 5, Qb = u & 31, b = bh >> 3, h = bh & 7;
        __syncthreads();
        mb::stage_kv(F.KB, F.VB, (size_t)b * T + Qb * 256, h * HD, lds0, wid, lane);
        const size_t row0 = (size_t)b * T + Qb * 256 + wid * 32;
        mb::bf16x8 qr[4];
#pragma unroll
        for (int d0 = 0; d0 < 4; ++d0) qr[d0] = *(const mb::bf16x8*)(F.QB + (row0 + r32) * AW + h * HD + 16 * d0 + 8 * hi);
        asm volatile("s_waitcnt vmcnt(0) lgkmcnt(0)" ::: "memory");
        __syncthreads();
        float m, l; mb::f32x16 o[2];
        mb::attend256<true>(qr, ldsc, lds0, lane, wid * 32 + r32, wid >> 1, m, l, o);
        if (hi == 0) { wsf[r32] = m; wsf[32 + r32] = l; }
        mb::stage_o(o, stg, lane);
        LDS_WAIT(); asm volatile("" ::: "memory");
        const int nv = Qb < 3 ? Qb : 3;
#pragma unroll
        for (int i = 0; i < 4; ++i) { const int q = i * 8 + (lane >> 3), ch = lane & 7; const size_t rq = row0 + q; const size_t pb = (rq * NH + h) * 3;
            const float mo = wsf[q], lo_ = wsf[32 + q];
            f32x4 a0 = *(const LAS f32x4*)(stg + q * 68 + ch * 8), a1 = *(const LAS f32x4*)(stg + q * 68 + ch * 8 + 4);
            float2 ml[3]; float M = mo;
#pragma unroll
            for (int s = 0; s < 3; ++s) if (s < nv) { ml[s] = F.PM[pb + s]; M = fmaxf(M, ml[s].x); }
            const float f = __builtin_amdgcn_exp2f(mo - M); float Ls = f * lo_; a0 = a0 * f; a1 = a1 * f;
#pragma unroll
            for (int s = 0; s < 3; ++s) if (s < nv) { const float fs = __builtin_amdgcn_exp2f(ml[s].x - M); Ls += fs * ml[s].y;
                const v4u w = *(const GAS v4u*)(F.PO + (pb + s) * 64 + ch * 8);
                a0.x += fs * __uint_as_float(w.x << 16); a0.y += fs * __uint_as_float(w.x & 0xffff0000u); a0.z += fs * __uint_as_float(w.y << 16); a0.w += fs * __uint_as_float(w.y & 0xffff0000u);
                a1.x += fs * __uint_as_float(w.z << 16); a1.y += fs * __uint_as_float(w.z & 0xffff0000u); a1.z += fs * __uint_as_float(w.w << 16); a1.w += fs * __uint_as_float(w.w & 0xffff0000u); }
            const float inv = 1.0f / Ls; a0 = a0 * inv; a1 = a1 * inv;
            v4u w; w.x = pk2(a0.x, a0.y); w.y = pk2(a0.z, a0.w); w.z = pk2(a1.x, a1.y); w.w = pk2(a1.z, a1.w);
            *(GAS v4u*)(F.A2 + rq * D + 512 + h * HD + ch * 8) = w; }
        LDS_WAIT(); asm volatile("" ::: "memory");
    }
    __syncthreads();
}

#ifndef PROBE_ATT
#define PROBE_ATT 0
#endif
__device__ __forceinline__ void probe_att_compare(Ctx& F) {
    float sd = 0.f, sr = 0.f;
    for (int r = F.gw; r < MP; r += F.NGW) {
        for (int j = 0; j < 8; ++j) { const int c = j * 64 + F.lane;
            const float a = __uint_as_float((unsigned)F.A2[(size_t)r * D + 512 + c] << 16), ref = __uint_as_float((unsigned)F.A2REF[(size_t)r * AW + c] << 16);
            sd += (a - ref) * (a - ref); sr += ref * ref; }
    }
    sd = wave_sum(sd); sr = wave_sum(sr);
    if (F.lane == 0) { atomicAdd((float*)(F.ctl + 16), sd); atomicAdd((float*)(F.ctl + 17), sr); }
}

__device__ __forceinline__ void dec_gemm(Ctx& F, const bf16* A, const bf16* Bt, float* C, int ldc, int N, int K, int wg0, int nwg) {
    const int lane = F.lane, wid = F.wave, r32 = lane & 31, hi = lane >> 5, rt = wid & 3, kh = wid >> 2;
    const int me = (int)blockIdx.x - wg0;
    if (me < 0 || me >= nwg) return;
    LAS float* red = (LAS float*)F.lds;
    for (int du = me; du < N / 32; du += nwg) {
        const int n0 = du * 32;
        const bf16* ap = A + (size_t)(rt * 32 + r32) * K + kh * (K / 2) + 8 * hi;
        const bf16* bp = Bt + (size_t)(n0 + r32) * K + kh * (K / 2) + 8 * hi;
        mb::f32x16 acc = {};
#pragma unroll 8
        for (int k = 0; k < K / 2; k += 16) {
            const mb::bf16x8 a = *(const mb::bf16x8*)(ap + k), b = *(const mb::bf16x8*)(bp + k);
            acc = __builtin_amdgcn_mfma_f32_32x32x16_bf16(a, b, acc, 0, 0, 0);
        }
        __syncthreads();
        if (kh == 1) {
#pragma unroll
            for (int r = 0; r < 16; ++r) red[(rt * 16 + r) * 64 + lane] = acc[r];
        }
        __syncthreads();
        if (kh == 0) {
#pragma unroll
            for (int r = 0; r < 16; ++r) C[(size_t)(rt * 32 + mb::crow(r, hi)) * ldc + n0 + r32] = acc[r] + red[(rt * 16 + r) * 64 + lane];
        }
    }
    __syncthreads();
}

__device__ __forceinline__ void dec_att_partials(Ctx& F) {
    const int lane = F.lane;
    LAS float* qs = (LAS float*)(F.lds + 65536 + F.wave * 1024);
    LAS float* ps = qs + 64;
    for (int it = F.gw; it < DB * NH * 6; it += F.NGW) {
        const int bh = it / 6, sub = it - bh * 6, b = bh >> 3, h = bh & 7, ksel = sub >> 1, half = sub & 1;
        LDS_WAIT(); asm volatile("" ::: "memory");
        qs[lane] = F.QF[(size_t)(MP + b) * AW + h * HD + lane];
        LDS_WAIT(); asm volatile("" ::: "memory");
        float gate = -INFINITY;
        if (lane < NBLK_D) { const float* km = F.KMD + ((size_t)b * NBLK_D + lane) * AW + h * HD; float acc = 0.f;
#pragma unroll
            for (int d4 = 0; d4 < 16; ++d4) { const f32x4 kv = *(const f32x4*)(km + 4 * d4); const f32x4 qv = *(const LAS f32x4*)(qs + 4 * d4); acc += (kv.x * qv.x + kv.y * qv.y) + (kv.z * qv.z + kv.w * qv.w); }
            gate = acc; }
        int blk = 0;
#pragma unroll
        for (int k = 0; k < 3; ++k) { const float m = wave_max(gate); const unsigned long long bal = __ballot(gate == m); const int ix = __ffsll((long long)bal) - 1;
            if (k == ksel) blk = ix; if (lane == ix) gate = -INFINITY; }
        const int pg = F.page_table[b * NPAGES + 2 * blk + half];
        const float* kbase = F.cache_k + (size_t)pg * 128 * AW + h * HD;
        const float* vbase = F.cache_v + (size_t)pg * 128 * AW + h * HD;
        float s[2];
#pragma unroll
        for (int rr = 0; rr < 2; ++rr) { const float* kp = kbase + (size_t)(rr * 64 + lane) * AW; float acc = 0.f;
#pragma unroll
            for (int d4 = 0; d4 < 16; ++d4) { const f32x4 kv = *(const f32x4*)(kp + 4 * d4); const f32x4 qv = *(const LAS f32x4*)(qs + 4 * d4); acc += (kv.x * qv.x + kv.y * qv.y) + (kv.z * qv.z + kv.w * qv.w); }
            s[rr] = acc * 0.125f; }
        const float m = wave_max(fmaxf(s[0], s[1]));
        const float p0 = __expf(s[0] - m), p1 = __expf(s[1] - m);
        const float l = wave_sum(p0 + p1);
        ps[lane] = p0; ps[64 + lane] = p1;
        LDS_WAIT(); asm volatile("" ::: "memory");
        const int kq = lane >> 4, d4 = lane & 15;
        f32x4 acc = (f32x4){0.f, 0.f, 0.f, 0.f};
#pragma unroll 8
        for (int i = 0; i < 32; ++i) { const int key = i * 4 + kq; const f32x4 vv = *(const f32x4*)(vbase + (size_t)key * AW + d4 * 4); acc += vv * ps[key]; }
#pragma unroll
        for (int e = 0; e < 4; ++e) { float a = acc[e]; a += __shfl_xor(a, 16); a += __shfl_xor(a, 32); acc[e] = a; }
        if (lane < 16) *(f32x4*)(F.DPO + (size_t)it * HD + d4 * 4) = acc;
        if (lane == 0) F.DPM[it] = make_float2(m, l);
    }
}
__device__ __forceinline__ void dec_att_combine(Ctx& F) {
    const int lane = F.lane;
    for (int bh = F.gw; bh < DB * NH; bh += F.NGW) {
        const int b = bh >> 3, h = bh & 7;
        const float qv = F.QF[(size_t)(MP + b) * AW + h * HD + lane], kv = F.out[O_KS + (size_t)b * AW + h * HD + lane], vv = F.out[O_VS + (size_t)b * AW + h * HD + lane];
        const float so = wave_sum(qv * kv) * 0.125f;
        float2 ml[6]; float M = so;
#pragma unroll
        for (int i = 0; i < 6; ++i) { ml[i] = F.DPM[bh * 6 + i]; M = fmaxf(M, ml[i].x); }
        const float fo = __expf(so - M); float L = fo, acc = fo * vv;
#pragma unroll
        for (int i = 0; i < 6; ++i) { const float f = __expf(ml[i].x - M); L += f * ml[i].y; acc += f * F.DPO[(size_t)(bh * 6 + i) * HD + lane]; }
        F.A2[(size_t)(MP + b) * D + 512 + h * HD + lane] = (bf16)f2bf(acc / L);
    }
}

constexpr int N_PHASES = 13;
__global__ void __launch_bounds__(NTHREADS, 2) fwd(Args args) {
    extern __shared__ __attribute__((aligned(16))) unsigned char lds[];
    Ctx F;
    F.lds = (LAS unsigned char*)lds;
    F.tid = threadIdx.x; F.lane = F.tid & 63; F.wave = __builtin_amdgcn_readfirstlane(F.tid >> 6);
    F.G = gridDim.x; F.gw = blockIdx.x * NWAVES + F.wave; F.NGW = F.G * NWAVES;
    F.x_prompt = (const float*)args.in[0]; F.x_sample = (const float*)args.in[1]; F.c_prompt = (const float*)args.in[2]; F.c_sample = (const float*)args.in[3];
    F.cache_k = (const float*)args.in[4]; F.cache_v = (const float*)args.in[5]; F.page_table = (const int*)args.in[6]; F.state_pool = (const float*)args.in[7]; F.state_conv = (const float*)args.in[8];
    F.w_ada = (const float*)args.in[9]; F.b_ada = (const float*)args.in[10]; F.g_mix_pre = (const float*)args.in[11]; F.g_mix_post = (const float*)args.in[12]; F.w_in = (const float*)args.in[13];
    F.pool_w = (const float*)args.in[14]; F.pool_scale = (const float*)args.in[15]; F.w_out = (const float*)args.in[16]; F.g_ffn_pre = (const float*)args.in[17]; F.g_ffn_post = (const float*)args.in[18];
    F.w_up = (const float*)args.in[19]; F.conv_w = (const float*)args.in[20]; F.conv_b = (const float*)args.in[21]; F.w_down = (const float*)args.in[22];
    F.out = args.out;
    unsigned char* ws = args.ws;
    F.WIN = (bf16*)(ws + WS_WIN); F.WO2 = (bf16*)(ws + WS_WO2); F.WUP = (bf16*)(ws + WS_WUP); F.WDN = (bf16*)(ws + WS_WDN);
    F.MOD = (float*)(ws + WS_MOD); F.ROPE = (float2*)(ws + WS_ROPE); F.KMD = (float*)(ws + WS_KMD); F.KMP = (float*)(ws + WS_KMP);
    F.XN = (bf16*)(ws + WS_XN); F.PROJ = (float*)(ws + WS_PROJ); F.QF = (float*)(ws + WS_QF); F.A2 = (bf16*)(ws + WS_A2); F.MIX = (float*)(ws + WS_MIX);
    F.QB = (bf16*)(ws + WS_QB); F.KB = (bf16*)(ws + WS_KB); F.VB = (bf16*)(ws + WS_VB); F.LIST = (unsigned short*)(ws + WS_LIST); F.COUNT = (int*)(ws + WS_COUNT); F.PO = (bf16*)(ws + WS_PO); F.PM = (float2*)(ws + WS_PM); F.A2REF = (bf16*)(ws + WS_A2REF); F.ctl = (unsigned*)(ws + WS_CTL); F.U = (float*)(ws + WS_U); F.KSUM = (float*)(ws + WS_KSUM); F.DPO = (float*)(ws + WS_DPO); F.DPM = (float2*)(ws + WS_DPM);
    F.X1 = (float*)(ws + WS_X1); F.UP = (float*)(ws + WS_UP); F.ACT = (bf16*)(ws + WS_ACT); F.FFN = (float*)(ws + WS_FFN);

    volatile LAS unsigned* MISC = (volatile LAS unsigned*)(F.lds + MISC_OFF);
    for (int u = F.tid; u < (LDS_BYTES - LDSCTL_OFF) / 4; u += NTHREADS) ((LAS unsigned*)(F.lds + LDSCTL_OFF))[u] = 0u;
    __syncthreads();
    const int lo = args.ph_lo, hi = args.ph_hi;
    const bool multi = (hi - lo) > 1;
    XcdBarrier bar; bar.bar = (unsigned*)(ws + WS_CTL) + CW_BAR; bar.x = 0; bar.st = nullptr;
    if (multi) bar = xcd_barrier_post((unsigned*)(ws + WS_CTL) + CW_BAR, MISC + 8);
#define IN(k) (lo <= (k) && (k) < hi)
#define SEAM(k) do { if (IN(k) && IN((k) + 1)) xcd_barrier(bar); } while (0)

#ifndef PROBE_DUP
#define PROBE_DUP 0
#endif
#define DUP(k) (((PROBE_DUP) >> (k)) & 1)
#define RUNP(k, ...) if (IN(k)) { asm volatile("" : "+v"(F.lane), "+v"(F.tid)); __VA_ARGS__; if (DUP(k)) { __syncthreads(); __VA_ARGS__; } } SEAM(k);
#define GEMM_F32(Aop, Bop, Cout, Nn, Kk, W0, NW) { pg8::Gemm g{Aop, Bop, MP, Nn, Kk}; pg8::StaticOrder S; S.init(MP, Nn, F.G, (int)blockIdx.x); pg8::EpiF32 E{Cout, Nn, nullptr}; \
        pg8::gemm_phase<pg8::EpiF32, pg8::StaticOrder, PG8_ALIGN, PG8_SP2>(F.lds, g, S, E); \
        dec_gemm(F, (Aop) + (size_t)MP * (Kk), Bop, (Cout) + (size_t)MP * (Nn), Nn, Nn, Kk, W0, NW); }
    RUNP(0, p0_prologue(F))
    RUNP(1, p1_norm_in(F))
    RUNP(2, { pg8::Gemm g{F.XN, F.WIN, MP, INW, D}; pg8::StaticOrder S; S.init(MP, INW, F.G, (int)blockIdx.x);
        pg8::EpiProj E{F.U, F.QB, F.KB, F.VB, F.out + O_KP, F.out + O_VP, F.KSUM, (const float*)F.ROPE, mb::C2};
        pg8::gemm_phase<pg8::EpiProj, pg8::StaticOrder, PG8_ALIGN, PG8_SP2>(F.lds, g, S, E);
        dec_gemm(F, F.XN + (size_t)MP * D, F.WIN, F.PROJ + (size_t)MP * INW, INW, INW, D, 0, 256); })
    RUNP(3, p3_post_proj(F); p3_pool_prompt(F))
#if PROBE_ATT
    RUNP(4, s1a_select(F); p4_attention_naive<false>(F); p4_attention_naive<true>(F))
#else
    RUNP(4, s1a_select(F); dec_att_partials(F))
#endif
    RUNP(5, dec_att_combine(F); s2_past(F))
    RUNP(6, s1b_own_merge(F))
    RUNP(7, GEMM_F32(F.A2, F.WO2, F.MIX, D, D, 0, 256))
#if PROBE_ATT
    RUNP(8, p6_mid_norm(F); probe_att_compare(F))
#else
    RUNP(8, p6_mid_norm(F))
#endif
    RUNP(9, { pg8::Gemm g{F.XN, F.WUP, 66 * 256, FF2, D}; pg8::ConvOrder S; S.init(66 * 256, FF2, F.G, (int)blockIdx.x);
        pg8::EpiConv E{F.ACT, F.conv_w, F.conv_b, F.out + O_CP, (LAS float*)(F.lds + 131072)};
        pg8::gemm_phase<pg8::EpiConv, pg8::ConvOrder, true, PG8_SP2>(F.lds, g, S, E);
        dec_gemm(F, F.XN + (size_t)MP * D, F.WUP, F.UP + (size_t)MP * FF2, FF2, FF2, D, 172, 84); })
    RUNP(10, p8_conv_act(F))
    RUNP(11, GEMM_F32(F.ACT, F.WDN, F.FFN, D, FF, 0, 256))
    if (IN(12)) { asm volatile("" : "+v"(F.lane), "+v"(F.tid)); p10_final(F); if (DUP(12)) p10_final(F);
#if PROBE_ATT
        if (blockIdx.x == 0 && F.tid == 0) { const float sd = __hip_atomic_load((float*)(F.ctl + 16), __ATOMIC_RELAXED, __HIP_MEMORY_SCOPE_AGENT), sr = __hip_atomic_load((float*)(F.ctl + 17), __ATOMIC_RELAXED, __HIP_MEMORY_SCOPE_AGENT);
            F.out[O_PP] += 100.0f * sqrtf(sd / fmaxf(sr, 1e-30f)); }
#endif
    }
#undef IN
#undef SEAM
}

#ifndef MK_ONE_LAUNCH
#define MK_ONE_LAUNCH 1
#endif
extern "C" void kernel_launch(void* const* d_in, const int* in_sizes, int n_in, void* d_out, int out_size, void* d_ws, size_t ws_size, hipStream_t stream) {
    static int grid = 0;
    if (grid == 0) {
        if (n_in != 23 || out_size != (int)O_END || ws_size < WS_END) { fprintf(stderr, "kernel_launch: unexpected shapes n_in %d out %d ws %zu\n", n_in, out_size, ws_size); grid = -1; return; }
        int dev = 0, cus = 0;
        if (hipGetDevice(&dev) != hipSuccess || hipDeviceGetAttribute(&cus, hipDeviceAttributeMultiprocessorCount, dev) != hipSuccess) { grid = -1; return; }
        if (hipFuncSetAttribute((const void*)fwd, hipFuncAttributeMaxDynamicSharedMemorySize, LDS_BYTES) != hipSuccess) { fprintf(stderr, "kernel_launch: hipFuncSetAttribute failed\n"); grid = -1; return; }
        int per_cu = 0;
        if (hipOccupancyMaxActiveBlocksPerMultiprocessor(&per_cu, (const void*)fwd, NTHREADS, LDS_BYTES) != hipSuccess || per_cu < 1) fprintf(stderr, "kernel_launch: occupancy query says %d\n", per_cu);
        (void)hipGetLastError();
        grid = cus;
    }
    if (grid < 0) return;
    (void)hipMemsetAsync((char*)d_ws + WS_CTL, 0, CTL_ZERO_BYTES, stream);
    Args a{};
    for (int i = 0; i < 23; ++i) a.in[i] = d_in[i];
    a.out = (float*)d_out; a.ws = (unsigned char*)d_ws;
#if MK_ONE_LAUNCH
    a.ph_lo = 0; a.ph_hi = N_PHASES;
    hipLaunchKernelGGL(fwd, dim3(grid), dim3(NTHREADS), LDS_BYTES, stream, a);
#else
    for (int p = 0; p < N_PHASES; ++p) { a.ph_lo = p; a.ph_hi = p + 1; hipLaunchKernelGGL(fwd, dim3(grid), dim3(NTHREADS), LDS_BYTES, stream, a); }
#endif
}
```
